# Optimizing an MI355X kernel written in HIP

```python
import jax, jax.numpy as jnp
from jax import lax
import numpy as np

D_MODEL = 1024
BATCH = 2
SEQ = 8192
DEPTH = 2
DEC_BATCH = 128
DEC_SEQ = 4
PAST_LEN = 8192
PAGE_SIZE = 128

R_HEADS = 8
R_HEAD_DIM = 64
R_WIDTH = R_HEADS * R_HEAD_DIM
DECAY_LORA = 64
ICLR_LORA = 64
GATE_LORA = 128
SHIFT_W = 3 * R_WIDTH + DECAY_LORA + ICLR_LORA + GATE_LORA
A_HEADS = 8
KV_HEADS = 2
HEAD_DIM = 64
Q_WIDTH = A_HEADS * HEAD_DIM
KV_WIDTH = KV_HEADS * HEAD_DIM
GROUP = A_HEADS // KV_HEADS
WINDOW = 128
BLOCK = 128
ROPE_THETA = 10000.0
ATTN_SCALE = HEAD_DIM ** -0.5
IN_W = SHIFT_W + Q_WIDTH + 2 * KV_WIDTH + 2 * D_MODEL
D_FF = 4 * D_MODEL
ALPHA = (2 * DEPTH) ** 0.25
BETA = (8 * DEPTH) ** -0.25
LN_EPS = 1e-5
GN_EPS = 64e-5

kernel_name = 'rwkv7_swa_sink_gated_hybrid_step'


def layer_norm(x, g, b):
    xf = x.astype(jnp.float32)
    mu = jnp.mean(xf, -1, keepdims=True)
    var = jnp.mean(jnp.square(xf - mu), -1, keepdims=True)
    return ((xf - mu) * lax.rsqrt(var + LN_EPS)).astype(x.dtype) * g + b


def rope(x, pos):
    half = HEAD_DIM // 2
    inv_freq = ROPE_THETA ** (-jnp.arange(half, dtype=jnp.float32) / half)
    ang = pos.astype(jnp.float32)[:, None] * inv_freq[None, :]
    cos = jnp.cos(ang)[None, :, None, :]
    sin = jnp.sin(ang)[None, :, None, :]
    xf = x.astype(jnp.float32)
    x1, x2 = xf[..., :half], xf[..., half:]
    return jnp.concatenate([x1 * cos - x2 * sin, x2 * cos + x1 * sin], -1).astype(x.dtype)


def wkv7_scan(S0, r, logw, k, v, kk, a):
    def step(S, inp):
        r_t, lw_t, k_t, v_t, kk_t, a_t = inp
        sa = jnp.einsum('bhvk,bhk->bhv', S, -kk_t)
        S = (S * jnp.exp(lw_t)[:, :, None, :] + sa[..., None] * (kk_t * a_t)[:, :, None, :]
             + v_t[..., None] * k_t[:, :, None, :])
        return S, jnp.einsum('bhvk,bhk->bhv', S, r_t)
    xs = tuple(jnp.moveaxis(t, 1, 0) for t in (r, logw, k, v, kk, a))
    S, ys = lax.scan(step, S0, xs)
    return jnp.moveaxis(ys, 0, 1), S


def rwkv7_branch(z, z_prev, S0, P):
    B, T, _ = z.shape
    f32 = jnp.float32
    prev = jnp.concatenate([z_prev[:, None].astype(z.dtype), z[:, :-1]], axis=1)
    zs = (z + (prev - z) * P['mu_shift']).astype(f32)
    o1, o2, o3 = R_WIDTH, 2 * R_WIDTH, 3 * R_WIDTH
    o4, o5 = o3 + DECAY_LORA, o3 + DECAY_LORA + ICLR_LORA
    r, k, v = zs[..., :o1], zs[..., o1:o2], zs[..., o2:o3]
    wd, ad, gd = zs[..., o3:o4], zs[..., o4:o5], zs[..., o5:]
    pre_w = P['decay_base'].astype(f32) + jnp.tanh(wd) @ P['decay_up'].astype(f32)
    logw = -jnp.exp(-jax.nn.softplus(-pre_w) - 0.5)
    a = jax.nn.sigmoid(P['iclr_base'].astype(f32) + ad @ P['iclr_up'].astype(f32))
    g = jax.nn.sigmoid(gd) @ P['gate_up'].astype(f32)
    heads = lambda t: t.reshape(B, T, R_HEADS, R_HEAD_DIM)
    kk = heads(k * P['k_k'].astype(f32))
    kk = kk * lax.rsqrt(jnp.maximum(jnp.sum(kk * kk, -1, keepdims=True), 1e-24))
    k = k * (1.0 + (a - 1.0) * P['k_a'].astype(f32))
    r, logw, k, v, a = heads(r), heads(logw), heads(k), heads(v), heads(a)
    y, S = wkv7_scan(S0.astype(f32), r, logw, k, v, kk, a)
    mu = jnp.mean(y, -1, keepdims=True)
    var = jnp.mean(jnp.square(y - mu), -1, keepdims=True)
    y = ((y - mu) * lax.rsqrt(var + GN_EPS)).reshape(B, T, R_WIDTH)
    y = y * P['lnx_g'].astype(f32) + P['lnx_b'].astype(f32)
    bonus = jnp.sum(r * k * P['r_k'].astype(f32), -1, keepdims=True) * v
    y = (y + bonus.reshape(B, T, R_WIDTH)) * g
    return y.astype(z.dtype), S.astype(S0.dtype)


def sink_softmax(s, mask, sink):
    s = jnp.where(mask, s, -jnp.inf)
    sk = sink.astype(jnp.float32)[:, :, None, None]
    m = jnp.maximum(jnp.max(s, -1, keepdims=True), sk)
    p = jnp.exp(s - m)
    return p / (jnp.sum(p, -1, keepdims=True) + jnp.exp(sk - m))


def attn_prompt(q, k, v, sinks):
    B, T = q.shape[:2]
    nb = T // BLOCK
    f32 = jnp.float32
    qb = q.astype(f32).reshape(B, nb, BLOCK, KV_HEADS, GROUP, HEAD_DIM)
    def band(t):
        tb = t.astype(f32).reshape(B, nb, BLOCK, KV_HEADS, HEAD_DIM)
        prev = jnp.pad(tb[:, :-1], ((0, 0), (1, 0), (0, 0), (0, 0), (0, 0)))
        return jnp.concatenate([prev, tb], axis=2)
    kb, vb = band(k), band(v)
    s = jnp.einsum('bnqhgd,bnkhd->bnhgqk', qb, kb) * ATTN_SCALE
    qi = jnp.arange(BLOCK)[:, None] + BLOCK
    kj = jnp.arange(2 * BLOCK)[None, :]
    dist = qi - kj
    in_win = (dist >= 0) & (dist <= WINDOW)
    has_prev = (jnp.arange(nb) > 0)[:, None, None] | (kj >= BLOCK)[None]
    mask = (in_win[None] & has_prev)[:, None, None]
    p = sink_softmax(s, mask, sinks.reshape(KV_HEADS, GROUP))
    o = jnp.einsum('bnhgqk,bnkhd->bnqhgd', p, vb)
    return o.reshape(B, T, Q_WIDTH).astype(q.dtype)


def attn_sample(q, k, v, k_buf, v_buf, sinks):
    B, T = q.shape[:2]
    W = k_buf.shape[1]
    f32 = jnp.float32
    kc = jnp.concatenate([k_buf.astype(k.dtype), k], axis=1)
    vc = jnp.concatenate([v_buf.astype(v.dtype), v], axis=1)
    qpos = PAST_LEN + jnp.arange(T)
    kpos = PAST_LEN - W + jnp.arange(W + T)
    dist = qpos[:, None] - kpos[None, :]
    mask = (dist >= 0) & (dist <= WINDOW)
    qg = q.astype(f32).reshape(B, T, KV_HEADS, GROUP, HEAD_DIM)
    s = jnp.einsum('bqhgd,bkhd->bhgqk', qg, kc.astype(f32)) * ATTN_SCALE
    p = sink_softmax(s, mask, sinks.reshape(KV_HEADS, GROUP))
    o = jnp.einsum('bhgqk,bkhd->bqhgd', p, vc.astype(f32))
    return o.reshape(B, T, Q_WIDTH).astype(q.dtype), kc[:, -W:], vc[:, -W:]


def trunk_layer(x, pos, shift_prev, S0, k_buf, v_buf, wbuf, P):
    B, T, _ = x.shape
    z = jnp.einsum('btd,de->bte', x, P['w_in'])
    o_q = SHIFT_W
    o_k = o_q + Q_WIDTH
    o_v = o_k + KV_WIDTH
    o_ga = o_v + KV_WIDTH
    o_gb = o_ga + D_MODEL
    z_r = z[..., :o_q]
    q = rope(z[..., o_q:o_k].reshape(B, T, A_HEADS, HEAD_DIM), pos)
    k = rope(z[..., o_k:o_v].reshape(B, T, KV_HEADS, HEAD_DIM), pos)
    v = z[..., o_v:o_ga].reshape(B, T, KV_HEADS, HEAD_DIM)
    gate_r = jax.nn.sigmoid(z[..., o_ga:o_gb])
    gate_a = jax.nn.sigmoid(z[..., o_gb:])
    y_r, S_new = rwkv7_branch(z_r, shift_prev, S0, P)
    if k_buf is None:
        y_a = attn_prompt(q, k, v, P['sinks'])
        k_new, v_new = k[:, -wbuf:], v[:, -wbuf:]
    else:
        y_a, k_new, v_new = attn_sample(q, k, v, k_buf, v_buf, P['sinks'])
    mix = (gate_r * jnp.einsum('btc,cd->btd', y_r, P['w_br_rwkv'])
           + gate_a * jnp.einsum('btc,cd->btd', y_a, P['w_br_attn']))
    x = layer_norm(ALPHA * x + mix @ P['w_out'], P['ln1_g'], P['ln1_b'])
    h = jnp.square(jax.nn.relu(x @ P['w_ff_up']))
    x = layer_norm(ALPHA * x + h @ P['w_ff_down'], P['ln2_g'], P['ln2_b'])
    return x, z_r[:, -1], S_new, k_new, v_new


def setup_inputs(seed: int = 0) -> dict:
    key = jax.random.key(seed)
    ks = iter(jax.random.split(key, 32))
    f32 = jnp.float32
    nrm = lambda shape, s: jax.random.normal(next(ks), shape, f32) * s
    L = DEPTH
    wbuf = min(WINDOW, PAST_LEN)
    return {
        'x_prompt': nrm((BATCH, SEQ, D_MODEL), 1.0),
        'x_sample': nrm((DEC_BATCH, DEC_SEQ, D_MODEL), 1.0),
        'state_wkv': nrm((L, DEC_BATCH, R_HEADS, R_HEAD_DIM, R_HEAD_DIM), 0.5),
        'state_shift': nrm((L, DEC_BATCH, SHIFT_W), 1.0),
        'cache_k_win': nrm((L, DEC_BATCH, wbuf, KV_HEADS, HEAD_DIM), 1.0),
        'cache_v_win': nrm((L, DEC_BATCH, wbuf, KV_HEADS, HEAD_DIM), 1.0),
        'w_in': nrm((L, D_MODEL, IN_W), D_MODEL ** -0.5),
        'mu_shift': jax.random.uniform(next(ks), (L, SHIFT_W), f32),
        'decay_base': jax.random.uniform(next(ks), (L, R_WIDTH), f32, -6.0, -1.0),
        'decay_up': nrm((L, DECAY_LORA, R_WIDTH), 0.5 * DECAY_LORA ** -0.5),
        'iclr_base': nrm((L, R_WIDTH), 0.1),
        'iclr_up': nrm((L, ICLR_LORA, R_WIDTH), 0.5 * ICLR_LORA ** -0.5),
        'gate_up': nrm((L, GATE_LORA, R_WIDTH), GATE_LORA ** -0.5),
        'k_k': 0.85 + nrm((L, R_WIDTH), 0.05),
        'k_a': 1.0 + nrm((L, R_WIDTH), 0.05),
        'r_k': nrm((L, R_HEADS, R_HEAD_DIM), 0.1),
        'lnx_g': 1.0 + nrm((L, R_WIDTH), 0.05),
        'lnx_b': nrm((L, R_WIDTH), 0.02),
        'sinks': nrm((L, A_HEADS), 0.5),
        'w_br_rwkv': nrm((L, R_WIDTH, D_MODEL), BETA * R_WIDTH ** -0.5),
        'w_br_attn': nrm((L, Q_WIDTH, D_MODEL), BETA * Q_WIDTH ** -0.5),
        'w_out': nrm((L, D_MODEL, D_MODEL), BETA * D_MODEL ** -0.5),
        'ln1_g': 1.0 + nrm((L, D_MODEL), 0.05),
        'ln1_b': nrm((L, D_MODEL), 0.02),
        'w_ff_up': nrm((L, D_MODEL, D_FF), D_MODEL ** -0.5),
        'w_ff_down': nrm((L, D_FF, D_MODEL), BETA * D_FF ** -0.5),
        'ln2_g': 1.0 + nrm((L, D_MODEL), 0.05),
        'ln2_b': nrm((L, D_MODEL), 0.02),
    }


def reference(x_prompt, x_sample, state_wkv, state_shift, cache_k_win, cache_v_win,
              w_in, mu_shift, decay_base, decay_up, iclr_base, iclr_up, gate_up, k_k, k_a, r_k,
              lnx_g, lnx_b, sinks, w_br_rwkv, w_br_attn, w_out, ln1_g, ln1_b,
              w_ff_up, w_ff_down, ln2_g, ln2_b):
    wbuf = cache_k_win.shape[2]
    Bp, Tp, _ = x_prompt.shape
    Ts = x_sample.shape[1]
    pos_p = jnp.arange(Tp, dtype=jnp.int32)
    pos_s = PAST_LEN + jnp.arange(Ts, dtype=jnp.int32)
    hp, hs = x_prompt, x_sample
    p_wkv, p_shift, p_k, p_v = [], [], [], []
    s_wkv, s_shift, s_k, s_v = [], [], [], []
    for l in range(DEPTH):
        P = dict(w_in=w_in[l], mu_shift=mu_shift[l], decay_base=decay_base[l], decay_up=decay_up[l],
                 iclr_base=iclr_base[l], iclr_up=iclr_up[l], gate_up=gate_up[l], k_k=k_k[l], k_a=k_a[l],
                 r_k=r_k[l], lnx_g=lnx_g[l], lnx_b=lnx_b[l], sinks=sinks[l], w_br_rwkv=w_br_rwkv[l],
                 w_br_attn=w_br_attn[l], w_out=w_out[l], ln1_g=ln1_g[l], ln1_b=ln1_b[l],
                 w_ff_up=w_ff_up[l], w_ff_down=w_ff_down[l], ln2_g=ln2_g[l], ln2_b=ln2_b[l])
        shift0 = jnp.zeros((Bp, SHIFT_W), hp.dtype)
        S0 = jnp.zeros((Bp, R_HEADS, R_HEAD_DIM, R_HEAD_DIM), state_wkv.dtype)
        hp, sh, S, kb, vb = trunk_layer(hp, pos_p, shift0, S0, None, None, wbuf, P)
        p_wkv.append(S); p_shift.append(sh); p_k.append(kb); p_v.append(vb)
        hs, sh, S, kb, vb = trunk_layer(hs, pos_s, state_shift[l], state_wkv[l],
                                        cache_k_win[l], cache_v_win[l], wbuf, P)
        s_wkv.append(S); s_shift.append(sh); s_k.append(kb); s_v.append(vb)
    return (hp, hs,
            jnp.stack(p_wkv), jnp.stack(p_shift), jnp.stack(p_k), jnp.stack(p_v),
            jnp.stack(s_wkv), jnp.stack(s_shift), jnp.stack(s_k), jnp.stack(s_v))
```

```cpp
#include <hip/hip_runtime.h>
#include <cstdio>
#include <cstdint>

#define LAS __attribute__((address_space(3)))
#define GAS __attribute__((address_space(1)))
typedef _Float16 f16;
typedef _Float16 f16x2 __attribute__((ext_vector_type(2)));
typedef _Float16 f16x4 __attribute__((ext_vector_type(4)));
typedef _Float16 f16x8 __attribute__((ext_vector_type(8)));
typedef float f32x2 __attribute__((ext_vector_type(2)));
typedef float f32x4 __attribute__((ext_vector_type(4)));
typedef float f32x16 __attribute__((ext_vector_type(16)));
typedef unsigned u32x2 __attribute__((ext_vector_type(2)));
typedef unsigned u32x4 __attribute__((ext_vector_type(4)));

constexpr int D = 1024, SEQ = 8192, NB = 2, DEPTH = 2, DECB = 128, DECT = 4, PAST = 8192;
constexpr int MP = NB * SEQ, MS = DECB * DECT, M = MP + MS;
constexpr int RW = 512, SHW = 1792, INW = 4608, FF = 4096, WBUF = 128;
constexpr int OQ = 1792, OK_ = 2304, OV = 2432, OGR = 2560, OGA = 3584;
constexpr float ALPHA = 1.4142135623730951f;
constexpr float LN_EPS = 1e-5f, GN_EPS = 64e-5f;
constexpr int NWAVES = 8, NTHR = 512;
constexpr int CH = 64;
constexpr int NCH = SEQ / CH;

constexpr size_t MiB = 1u << 20;
constexpr size_t WS_CTL = 0, CTL_ZERO_BYTES = 1 * MiB;
constexpr size_t WS_ROPE = 1 * MiB;
constexpr size_t WS_LORA = 4 * MiB;
constexpr size_t LORA_STRIDE = 256 * 1024;
constexpr size_t WS_WIN = 5 * MiB, WS_WBR = 14 * MiB, WS_WOUT = 16 * MiB, WS_WUP = 18 * MiB, WS_WDN = 26 * MiB;
constexpr size_t WS_XH = 34 * MiB;
constexpr size_t WS_ZR = 67 * MiB;
constexpr size_t WS_YRA = 125 * MiB;
constexpr size_t WS_KB = 158 * MiB, WS_VB = 163 * MiB;
constexpr size_t WS_GG = 168 * MiB;
constexpr size_t WS_MIX = 185 * MiB;
constexpr size_t WS_YSC = 218 * MiB;
constexpr size_t WS_H = 67 * MiB;
constexpr size_t WS_END = 256 * MiB;
static_assert(WS_YSC + 32 * MiB <= WS_END && WS_H + (size_t)M * FF * 2 <= WS_YSC + 32 * MiB, "ws map");

constexpr size_t O_YP = 0, O_YS = O_YP + (size_t)MP * D, O_PWKV = O_YS + (size_t)MS * D, O_PSH = O_PWKV + (size_t)DEPTH * NB * 8 * 64 * 64,
    O_PK = O_PSH + (size_t)DEPTH * NB * SHW, O_PV = O_PK + (size_t)DEPTH * NB * WBUF * 128, O_SWKV = O_PV + (size_t)DEPTH * NB * WBUF * 128,
    O_SSH = O_SWKV + (size_t)DEPTH * DECB * 8 * 64 * 64, O_SK = O_SSH + (size_t)DEPTH * DECB * SHW, O_SV = O_SK + (size_t)DEPTH * DECB * WBUF * 128,
    O_END = O_SV + (size_t)DEPTH * DECB * WBUF * 128;

constexpr int CW_BAR = 4096;

constexpr int LDS_BYTES = 159744;
constexpr int MISC_OFF = 159232;

#define RLX_AGENT __ATOMIC_RELAXED, __HIP_MEMORY_SCOPE_AGENT
#define LDS_WAIT() asm volatile("s_waitcnt lgkmcnt(0)" ::: "memory")
#define VM_WAIT() asm volatile("s_waitcnt vmcnt(0)" ::: "memory")
__device__ __forceinline__ f16x4 cvt4(f32x4 v) { f16x4 r; r.x = (f16)v.x; r.y = (f16)v.y; r.z = (f16)v.z; r.w = (f16)v.w; return r; }
__device__ __forceinline__ f32x4 up4(f16x4 v) { f32x4 r; r.x = (float)v.x; r.y = (float)v.y; r.z = (float)v.z; r.w = (float)v.w; return r; }
__device__ __forceinline__ float rcpf_(float x) { return __builtin_amdgcn_rcpf(x); }
__device__ __forceinline__ float rsqf_(float x) { return __builtin_amdgcn_rsqf(x); }
__device__ __forceinline__ float sigmoidf_(float x) { return rcpf_(1.0f + __expf(-x)); }
__device__ __forceinline__ float wave_sum(float v) {
#pragma unroll
    for (int o = 1; o < 64; o <<= 1) v += __shfl_xor(v, o);
    return v;
}
__device__ __forceinline__ float wave_max(float v) {
#pragma unroll
    for (int o = 1; o < 64; o <<= 1) v = fmaxf(v, __shfl_xor(v, o));
    return v;
}

#define XB_TMO      128
#define XB_XCNT(j)  (256  + 64 * (j))
#define XB_XSUB(j)  (1280 + 64 * (j))
#define XB_XGEN(j)  (2304 + 64 * (j))
#define XB_TOP      3328
#define XB_TOPGEN   3392
#define XCD_BAR_WORDS 3456
#define XB_SPIN_CAP (1u << 20)
__device__ __forceinline__ unsigned xb_ld(unsigned* p)              { return __hip_atomic_load(p, __ATOMIC_RELAXED, __HIP_MEMORY_SCOPE_AGENT); }
__device__ __forceinline__ unsigned xb_add(unsigned* p, unsigned v) { return __hip_atomic_fetch_add(p, v, __ATOMIC_RELAXED, __HIP_MEMORY_SCOPE_AGENT); }
__device__ __forceinline__ unsigned xb_xcc_id() { return (unsigned)__builtin_amdgcn_s_getreg((3 << 11) | 20) & 0xFu; }
#define XB_SPIN(cond, bar) do { unsigned _sp = 0; while (cond) { __builtin_amdgcn_s_sleep(1); \
    if ((++_sp & 255u) == 0u) { if (xb_ld(&(bar)[XB_TMO])) break; if (_sp > XB_SPIN_CAP) { atomicAdd(&(bar)[XB_TMO], 1u); break; } } } } while (0)
struct XcdBarrier { unsigned* bar; unsigned x; volatile LAS unsigned* st; };
__device__ __forceinline__ XcdBarrier xcd_barrier_post(unsigned* bar, volatile LAS unsigned* st) {
    XcdBarrier b; b.bar = bar; b.x = xb_xcc_id(); b.st = st;
    if (threadIdx.x == 0) (void)xb_add(&bar[XB_XCNT(b.x)], 1u);
    return b;
}
__device__ __forceinline__ void xcd_barrier_complete(unsigned* bar, unsigned x, unsigned& nloc, unsigned& nx) {
    const unsigned G = gridDim.x * gridDim.y * gridDim.z;
    unsigned sum, cnt, mine, sp = 0u;
    for (;;) {
        sum = 0u; cnt = 0u; mine = 0u;
#pragma unroll
        for (unsigned j = 0; j < 16; ++j) { const unsigned c = xb_ld(&bar[XB_XCNT(j)]); sum += c; cnt += (c > 0u) ? 1u : 0u; mine = (j == x) ? c : mine; }
        if (sum == G) break;
        __builtin_amdgcn_s_sleep(1);
        if ((++sp & 255u) == 0u) { if (xb_ld(&bar[XB_TMO])) break; if (sp > XB_SPIN_CAP) { atomicAdd(&bar[XB_TMO], 1u); break; } }
    }
    nloc = mine > 0u ? mine : 1u; nx = cnt > 0u ? cnt : 1u;
}
__device__ __forceinline__ void xcd_barrier(const XcdBarrier& b) {
    asm volatile("s_waitcnt vmcnt(0)" ::: "memory");
    __syncthreads();
    if (threadIdx.x == 0) {
        unsigned* bar = b.bar;
        __builtin_amdgcn_s_waitcnt(0);
        unsigned nloc = b.st[0], nx = b.st[1];
        if (nloc == 0u) { xcd_barrier_complete(bar, b.x, nloc, nx); b.st[0] = nloc; b.st[1] = nx; }
        const unsigned old = xb_add(&bar[XB_XSUB(b.x)], 1u);
        const unsigned gen = old / nloc;
        if (old + 1u == (gen + 1u) * nloc) {
            __builtin_amdgcn_fence(__ATOMIC_RELEASE, "agent");
            asm volatile("s_waitcnt vmcnt(0)" ::: "memory");
            const unsigned og = xb_add(&bar[XB_TOP], 1u);
            const unsigned tg = og / nx;
            if (og + 1u == (tg + 1u) * nx) xb_add(&bar[XB_TOPGEN], 1u);
            else XB_SPIN(xb_ld(&bar[XB_TOPGEN]) == tg, bar);
            __builtin_amdgcn_fence(__ATOMIC_ACQUIRE, "agent");
            xb_add(&bar[XB_XGEN(b.x)], 1u);
            asm volatile("s_waitcnt vmcnt(0)" ::: "memory");
        } else {
            XB_SPIN(xb_ld(&bar[XB_XGEN(b.x)]) == gen, bar);
            __builtin_amdgcn_fence(__ATOMIC_ACQUIRE, "agent");
            asm volatile("s_waitcnt vmcnt(0)" ::: "memory");
        }
    }
    __syncthreads();
}

namespace pg8 {
constexpr int BM = 256, BK = 64, HALF = 128, HTB = HALF * BK * 2, STAGE_BYTES = 8 * HTB;
__host__ __device__ __forceinline__ int lds_byte(int r, int c) { const int st = (r >> 4) * 2 + (c >> 5), rr = r & 15, cc = c & 31, ob = rr * 64 + cc * 2; return st * 1024 + (ob ^ (((ob >> 9) & 1) << 5)); }
__host__ __device__ __forceinline__ void stage_rc(int b, int& R, int& C) { const int st = b / 1024, sb = b % 1024, swz = sb ^ (((sb >> 9) & 1) << 5); R = (st >> 1) * 16 + swz / 64; C = (st & 1) * 32 + (swz % 64) / 2; }
__host__ __device__ __forceinline__ int permrow(int R) { const int wc = R >> 5, n = (R >> 4) & 1, i = R & 15; return 64 * (wc >> 1) + 16 * (wc & 1) + i + 32 * n; }
struct Unit { const char* A; const char* B; int nt, pm, pn, kind; };

template <class Epi, class Sched>
__device__ __forceinline__ void gemm_phase(LAS unsigned char* lds, const int lda, const int ldb, const Sched& S, const Epi& E, const int tid) {
    const int wid = __builtin_amdgcn_readfirstlane(tid >> 6), lane = tid & 63, wr = wid >> 2, wc = wid & 3, fr = lane & 15, fq = lane >> 4;
    unsigned voffA[2], voffB[2];
#pragma unroll
    for (int i = 0; i < 2; ++i) { int R, C; stage_rc(tid * 16 + i * 8192, R, C); const int Rb = permrow(R);
        voffA[i] = (unsigned)(R * lda + C) * 2u; voffB[i] = (unsigned)(Rb * ldb + C) * 2u; }
    const size_t kstep = (size_t)(BK * 2);
    const size_t hstepA = (size_t)HALF * lda * 2, hstepB = (size_t)HALF * ldb * 2;
    const unsigned ldsw = (unsigned)wid * 1024u;
    const int aoff = lds_byte(wr * 64 + fr, fq * 8), boff = lds_byte(wc * 32 + fr, fq * 8);
#define PG8_SA(b, h) (((b) * 2 + (h)) * HTB)
#define PG8_SB(b, h) ((4 + (b) * 2 + (h)) * HTB)
#define PG8_STAGE(bufoff, gbase, voff) do { _Pragma("unroll") for (int _i = 0; _i < 2; ++_i) \
        __builtin_amdgcn_global_load_lds((const unsigned*)((const char*)(gbase) + (voff)[_i]), (LAS unsigned*)(lds + (bufoff) + ldsw + _i * 8192), 16, 0, 0); } while (0)
#define PG8_LDA(dst, b, h) do { _Pragma("unroll") for (int m = 0; m < 4; ++m) _Pragma("unroll") for (int k = 0; k < 2; ++k) dst[m][k] = *(const LAS f16x8*)(lds + PG8_SA(b, h) + aoff + m * 2048 + k * 1024); } while (0)
#define PG8_LDB(dst, b, h) do { _Pragma("unroll") for (int n = 0; n < 2; ++n) _Pragma("unroll") for (int k = 0; k < 2; ++k) dst[n][k] = *(const LAS f16x8*)(lds + PG8_SB(b, h) + boff + n * 2048 + k * 1024); } while (0)
#define PG8_MMA(ai, bj, At, Bt) do { __builtin_amdgcn_s_setprio(1); _Pragma("unroll") for (int m = 0; m < 4; ++m) _Pragma("unroll") for (int n = 0; n < 2; ++n) _Pragma("unroll") for (int k = 0; k < 2; ++k) \
        acc[ai][bj][m][n] = __builtin_amdgcn_mfma_f32_16x16x32_f16(Bt[n][k], At[m][k], acc[ai][bj][m][n], 0, 0, 0); __builtin_amdgcn_s_setprio(0); } while (0)
#define PG8_WAIT_V(n) asm volatile("s_waitcnt vmcnt(" #n ")" ::: "memory")
#define PG8_WAIT_L(n) asm volatile("s_waitcnt lgkmcnt(" #n ")" ::: "memory")
#define PG8_BAR __builtin_amdgcn_s_barrier()
#define PG8_SCHED __builtin_amdgcn_sched_barrier(0)
    Unit cur, nxt; int ui = 0;
    if (!S.next(0, cur)) return;
    f32x4 acc[2][2][4][2];
#pragma unroll
    for (int a = 0; a < 2; ++a)
#pragma unroll
        for (int b = 0; b < 2; ++b)
#pragma unroll
            for (int m = 0; m < 4; ++m)
#pragma unroll
                for (int n = 0; n < 2; ++n) acc[a][b][m][n] = (f32x4){0.f, 0.f, 0.f, 0.f};
    f16x8 At[4][2], B0[2][2], B1[2][2];
    const char* cA = cur.A; const char* cB = cur.B;
    PG8_STAGE(PG8_SB(0, 0), cB, voffB); PG8_STAGE(PG8_SB(0, 1), cB + hstepB, voffB); PG8_STAGE(PG8_SA(0, 0), cA, voffA); PG8_STAGE(PG8_SA(0, 1), cA + hstepA, voffA);
    if (wr == 1) PG8_BAR;
    PG8_WAIT_V(2); PG8_BAR;
    PG8_STAGE(PG8_SB(1, 0), cB + kstep, voffB); PG8_STAGE(PG8_SA(1, 0), cA + kstep, voffA); PG8_STAGE(PG8_SB(1, 1), cB + hstepB + kstep, voffB);
    PG8_WAIT_V(6); PG8_BAR;
    for (;;) {
        const bool has_next = S.next(ui + 1, nxt);
        const char* nA = has_next ? nxt.A : cA; const char* nB = has_next ? nxt.B : cB;
        const int nt = cur.nt;
        for (int t = 0; t < nt; t += 2) {
            const bool last = (t == nt - 2);
            const char* a1 = cA + (size_t)(t + 1) * kstep;
            const char* a2 = last ? nA : cA + (size_t)(t + 2) * kstep; const char* b2 = last ? nB : cB + (size_t)(t + 2) * kstep;
            const char* a3 = a2 + kstep; const char* b3 = b2 + kstep;
            PG8_LDB(B0, 0, 0); PG8_LDB(B1, 0, 1); PG8_SCHED; PG8_LDA(At, 0, 0); PG8_STAGE(PG8_SA(1, 1), a1 + hstepA, voffA);
            PG8_WAIT_V(8); PG8_WAIT_L(0); PG8_BAR; PG8_MMA(0, 0, At, B0); PG8_MMA(0, 1, At, B1); PG8_BAR; PG8_SCHED;
            PG8_LDA(At, 0, 1); PG8_STAGE(PG8_SB(0, 0), b2, voffB); PG8_STAGE(PG8_SB(0, 1), b2 + hstepB, voffB); PG8_STAGE(PG8_SA(0, 0), a2, voffA);
            PG8_WAIT_V(8); PG8_WAIT_L(0); PG8_BAR; PG8_MMA(1, 0, At, B0); PG8_MMA(1, 1, At, B1); PG8_BAR; PG8_SCHED;
            PG8_LDB(B0, 1, 0); PG8_LDB(B1, 1, 1); PG8_SCHED; PG8_LDA(At, 1, 0); PG8_STAGE(PG8_SA(0, 1), a2 + hstepA, voffA);
            PG8_WAIT_V(8); PG8_WAIT_L(0); PG8_BAR; PG8_MMA(0, 0, At, B0); PG8_MMA(0, 1, At, B1); PG8_BAR; PG8_SCHED;
            PG8_LDA(At, 1, 1); PG8_STAGE(PG8_SB(1, 0), b3, voffB); PG8_STAGE(PG8_SB(1, 1), b3 + hstepB, voffB); PG8_STAGE(PG8_SA(1, 0), a3, voffA);
            PG8_WAIT_V(8); PG8_WAIT_L(0); PG8_BAR; PG8_MMA(1, 0, At, B0); PG8_MMA(1, 1, At, B1); PG8_BAR; PG8_SCHED;
        }
        if (wr == 0) PG8_BAR;
        E(acc, cur, wr, wc, fr, fq);
        if (!has_next) break;
#pragma unroll
        for (int a = 0; a < 2; ++a)
#pragma unroll
            for (int b = 0; b < 2; ++b)
#pragma unroll
                for (int m = 0; m < 4; ++m)
#pragma unroll
                    for (int n = 0; n < 2; ++n) acc[a][b][m][n] = (f32x4){0.f, 0.f, 0.f, 0.f};
        cur = nxt; cA = nA; cB = nB; ++ui;
        if (wr == 1) PG8_BAR;
    }
    PG8_WAIT_V(0);
    PG8_BAR;
#undef PG8_SA
#undef PG8_SB
#undef PG8_STAGE
#undef PG8_LDA
#undef PG8_LDB
#undef PG8_MMA
#undef PG8_WAIT_V
#undef PG8_WAIT_L
#undef PG8_BAR
#undef PG8_SCHED
}
template <class F>
__device__ __forceinline__ void epi_iter(const f32x4 (&acc)[2][2][4][2], const Unit& u, int wr, int wc, int fr, int fq, const F& f) {
#pragma unroll
    for (int ai = 0; ai < 2; ++ai)
#pragma unroll
        for (int m = 0; m < 4; ++m) {
            const int row = u.pm * BM + ai * HALF + wr * 64 + m * 16 + fr;
#pragma unroll
            for (int bj = 0; bj < 2; ++bj) {
                const int col = u.pn * BM + bj * HALF + (wc >> 1) * 64 + (wc & 1) * 16 + 4 * fq;
                f(row, col, acc[ai][bj][m][0], acc[ai][bj][m][1], u.kind);
            }
        }
}
}

struct Args { const float* in[28]; float* out; unsigned char* ws; int ph_lo, ph_hi, li, pad; };
struct Frame {
    LAS unsigned char* lds;
    int tid, lane, wave, G, bid, gw, NGW;
    const float* const* in; float* out; unsigned char* ws;
};
#define WSP(T, off) ((T*)(F.ws + (off)))

template <class Fn>
__device__ __forceinline__ void small_tile(const f16* __restrict__ A, int lda, const f16* __restrict__ Bt, int ldb, int K, int row0, int col0, int kind, const Fn& f, int lane) {
    f32x16 acc0, acc1;
#pragma unroll
    for (int i = 0; i < 16; ++i) { acc0[i] = 0.f; acc1[i] = 0.f; }
    const f16* ap = A + (size_t)(row0 + (lane & 31)) * lda + 8 * (lane >> 5);
    const f16* b0 = Bt + (size_t)(col0 + (lane & 31)) * ldb + 8 * (lane >> 5);
    const f16* b1 = b0 + (size_t)32 * ldb;
#pragma unroll 4
    for (int k = 0; k < K; k += 16) {
        const f16x8 a = *(const f16x8*)(ap + k), x0 = *(const f16x8*)(b0 + k), x1 = *(const f16x8*)(b1 + k);
        acc0 = __builtin_amdgcn_mfma_f32_32x32x16_f16(x0, a, acc0, 0, 0, 0);
        acc1 = __builtin_amdgcn_mfma_f32_32x32x16_f16(x1, a, acc1, 0, 0, 0);
    }
    const int row = row0 + (lane & 31), cb = col0 + 4 * (lane >> 5);
#pragma unroll
    for (int g = 0; g < 4; ++g)
        f(row, cb + 8 * g, (f32x4){acc0[4 * g], acc0[4 * g + 1], acc0[4 * g + 2], acc0[4 * g + 3]}, (f32x4){acc1[4 * g], acc1[4 * g + 1], acc1[4 * g + 2], acc1[4 * g + 3]}, kind);
}

struct EpiG1 {
    f16* ZR; f16* YRA; f16* KB; f16* VB; const f32x2* rope; float* out; int l;
    __device__ __forceinline__ void operator()(int row, int col, f32x4 v0, f32x4 v1, int) const {
        if (col < OQ) {
            f16* p = ZR + (size_t)row * SHW + col;
            *(f16x4*)p = cvt4(v0); *(f16x4*)(p + 32) = cvt4(v1);
            const bool lastp = row < MP ? ((row & (SEQ - 1)) == SEQ - 1) : (((row - MP) & 3) == 3);
            if (lastp) {
                float* o = row < MP ? out + O_PSH + ((size_t)l * NB + (row >> 13)) * SHW + col : out + O_SSH + ((size_t)l * DECB + ((row - MP) >> 2)) * SHW + col;
                *(f32x4*)o = v0; *(f32x4*)(o + 32) = v1;
            }
        } else if (col < OV) {
            const int pos = row < MP ? (row & (SEQ - 1)) : PAST + ((row - MP) & 3);
            const int d = (col - OQ) & 63;
            const f32x4* rp = (const f32x4*)(rope + (size_t)pos * 32 + d);
            const f32x4 c01 = rp[0], c23 = rp[1];
            const f32x4 c = (f32x4){c01.x, c01.z, c23.x, c23.z}, s = (f32x4){c01.y, c01.w, c23.y, c23.w};
            f32x4 o1 = v0 * c - v1 * s, o2 = v1 * c + v0 * s;
            if (col < OK_) {
                f16* p = YRA + (size_t)row * 1024 + 512 + (col - OQ);
                *(f16x4*)p = cvt4(o1 * 0.125f); *(f16x4*)(p + 32) = cvt4(o2 * 0.125f);
            } else {
                const int kc = col - OK_;
                f16* p = KB + (size_t)row * 128 + kc;
                *(f16x4*)p = cvt4(o1); *(f16x4*)(p + 32) = cvt4(o2);
                if (row < MP) { const int t = row & (SEQ - 1); if (t >= SEQ - WBUF) { float* o = out + O_PK + (((size_t)l * NB + (row >> 13)) * WBUF + (t - (SEQ - WBUF))) * 128 + kc; *(f32x4*)o = o1; *(f32x4*)(o + 32) = o2; } }
                else { float* o = out + O_SK + (((size_t)l * DECB + ((row - MP) >> 2)) * WBUF + (WBUF - DECT + ((row - MP) & 3))) * 128 + kc; *(f32x4*)o = o1; *(f32x4*)(o + 32) = o2; }
            }
        } else {
            const int vc = col - OV;
            f16* p = VB + (size_t)row * 128 + vc;
            *(f16x4*)p = cvt4(v0); *(f16x4*)(p + 32) = cvt4(v1);
            if (row < MP) { const int t = row & (SEQ - 1); if (t >= SEQ - WBUF) { float* o = out + O_PV + (((size_t)l * NB + (row >> 13)) * WBUF + (t - (SEQ - WBUF))) * 128 + vc; *(f32x4*)o = v0; *(f32x4*)(o + 32) = v1; } }
            else { float* o = out + O_SV + (((size_t)l * DECB + ((row - MP) >> 2)) * WBUF + (WBUF - DECT + ((row - MP) & 3))) * 128 + vc; *(f32x4*)o = v0; *(f32x4*)(o + 32) = v1; }
        }
    }
};
__device__ __forceinline__ f32x4 sig4(f32x4 v) { return (f32x4){sigmoidf_(v.x), sigmoidf_(v.y), sigmoidf_(v.z), sigmoidf_(v.w)}; }
struct EpiMix {
    f16* MIX; f16* TMP;
    __device__ __forceinline__ void operator()(int row, int col, f32x4 v0, f32x4 v1, int kind) const {
        f16* p = MIX + (size_t)row * D + col; f16* q = TMP + (size_t)row * D + col;
        if (kind == 0) { *(f16x4*)p = cvt4(sig4(v0)); *(f16x4*)(p + 32) = cvt4(sig4(v1)); }
        else if (kind == 1) { const f32x4 m0 = up4(*(f16x4*)p), m1 = up4(*(f16x4*)(p + 32)); *(f16x4*)p = cvt4(m0 * v0); *(f16x4*)(p + 32) = cvt4(m1 * v1); }
        else if (kind == 2) { *(f16x4*)q = cvt4(sig4(v0)); *(f16x4*)(q + 32) = cvt4(sig4(v1)); }
        else { const f32x4 m0 = up4(*(f16x4*)p), m1 = up4(*(f16x4*)(p + 32)), t0 = up4(*(f16x4*)q), t1 = up4(*(f16x4*)(q + 32));
               *(f16x4*)p = cvt4(m0 + t0 * v0); *(f16x4*)(p + 32) = cvt4(m1 + t1 * v1); }
    }
};
struct EpiRes {
    f16* XH;
    __device__ __forceinline__ void operator()(int row, int col, f32x4 v0, f32x4 v1, int) const {
        f16* p = XH + (size_t)row * D + col;
        const f32x4 x0 = up4(*(f16x4*)p), x1 = up4(*(f16x4*)(p + 32));
        *(f16x4*)p = cvt4(x0 * ALPHA + v0); *(f16x4*)(p + 32) = cvt4(x1 * ALPHA + v1);
    }
};
struct EpiUp {
    f16* H;
    __device__ __forceinline__ void operator()(int row, int col, f32x4 v0, f32x4 v1, int) const {
        f16* p = H + (size_t)row * FF + col;
        f32x4 a = __builtin_elementwise_max(v0, (f32x4){0.f, 0.f, 0.f, 0.f}), b = __builtin_elementwise_max(v1, (f32x4){0.f, 0.f, 0.f, 0.f});
        *(f16x4*)p = cvt4(a * a); *(f16x4*)(p + 32) = cvt4(b * b);
    }
};
template <class Fn> struct EpiBig {
    Fn f;
    __device__ __forceinline__ void operator()(const f32x4 (&acc)[2][2][4][2], const pg8::Unit& u, int wr, int wc, int fr, int fq) const { pg8::epi_iter(acc, u, wr, wc, fr, fq, f); }
};

__device__ __forceinline__ bool tile_of(int L, int nM, int nN, int& pm, int& pn) {
    const int nwg = nM * nN; if (L >= nwg) return false;
    int wgid = L; { const int q = nwg / 8, r = nwg % 8, xcd = wgid % 8, off = wgid / 8; wgid = (xcd < r ? xcd * (q + 1) : r * (q + 1) + (xcd - r) * q) + off; }
    const int WGM = 8, nig = WGM * nN, gid = wgid / nig, fm = gid * WGM, gsz = (nM - fm) < WGM ? (nM - fm) : WGM;
    pm = fm + ((wgid % nig) % gsz); pn = (wgid % nig) / gsz; return true;
}
struct SchedPlain {
    const f16* A; const f16* B; int lda, ldb, nN, nt, G, c;
    __device__ __forceinline__ bool next(int i, pg8::Unit& u) const {
        int pm, pn; if (!tile_of(i * G + c, MP / 256, nN, pm, pn)) return false;
        u.A = (const char*)(A + (size_t)pm * 256 * lda); u.B = (const char*)(B + (size_t)pn * 256 * ldb); u.nt = nt; u.pm = pm; u.pn = pn; u.kind = 0; return true;
    }
};
struct SchedMix {
    const f16* XH; const f16* YRA; const f16* WIN; const f16* WBR; int G, c;
    __device__ __forceinline__ bool next(int i, pg8::Unit& u) const {
        int pm, pn; if (!tile_of((i >> 2) * G + c, MP / 256, 4, pm, pn)) return false;
        const int k = i & 3; u.pm = pm; u.pn = pn; u.kind = k;
        if (k == 0) { u.A = (const char*)(XH + (size_t)pm * 256 * D); u.B = (const char*)(WIN + (size_t)(OGR + pn * 256) * D); u.nt = 16; }
        else if (k == 1) { u.A = (const char*)(YRA + (size_t)pm * 256 * D); u.B = (const char*)(WBR + (size_t)pn * 256 * D); u.nt = 8; }
        else if (k == 2) { u.A = (const char*)(XH + (size_t)pm * 256 * D); u.B = (const char*)(WIN + (size_t)(OGA + pn * 256) * D); u.nt = 16; }
        else { u.A = (const char*)(YRA + (size_t)pm * 256 * D + 512); u.B = (const char*)(WBR + (size_t)pn * 256 * D + 512); u.nt = 8; }
        return true;
    }
};

__device__ __forceinline__ void transpose_item(const float* __restrict__ W, int K, int N, f16* __restrict__ dst, int ldd, int koff, LAS float* scr, int item, int lane) {
    const int nblk = N / 32, kb = item / nblk, nb = item % nblk, k0 = 64 * kb, n0 = 32 * nb;
#pragma unroll 8
    for (int i = 0; i < 32; ++i) { const int kk = 2 * i + (lane >> 5); scr[kk * 33 + (lane & 31)] = W[(size_t)(k0 + kk) * N + n0 + (lane & 31)]; }
    LDS_WAIT(); asm volatile("" ::: "memory");
    const int c = lane & 7;
#pragma unroll
    for (int j = 0; j < 4; ++j) { const int n = (lane >> 3) + 8 * j; const LAS float* s = scr + (8 * c) * 33 + n;
        f16x8 o; o[0] = (f16)s[0 * 33]; o[1] = (f16)s[1 * 33]; o[2] = (f16)s[2 * 33]; o[3] = (f16)s[3 * 33]; o[4] = (f16)s[4 * 33]; o[5] = (f16)s[5 * 33]; o[6] = (f16)s[6 * 33]; o[7] = (f16)s[7 * 33];
        *(f16x8*)(dst + (size_t)(n0 + n) * ldd + koff + k0 + 8 * c) = o; }
    LDS_WAIT(); asm volatile("" ::: "memory");
}
__device__ __forceinline__ void convert_layer_weights(Frame& F, int l) {
    LAS float* scr = (LAS float*)(F.lds + F.wave * 16384);
    constexpr int I_IN = (D / 64) * (INW / 32), I_BR = (RW / 64) * (D / 32), I_OUT = (D / 64) * (D / 32), I_UP = (D / 64) * (FF / 32), I_DN = (FF / 64) * (D / 32);
    constexpr int NIT = I_IN + 2 * I_BR + I_OUT + I_UP + I_DN;
    for (int it = F.gw; it < NIT; it += F.NGW) {
        int r = it;
        if (r < I_IN) { transpose_item(F.in[6] + (size_t)l * D * INW, D, INW, WSP(f16, WS_WIN), D, 0, scr, r, F.lane); continue; } r -= I_IN;
        if (r < I_BR) { transpose_item(F.in[19] + (size_t)l * RW * D, RW, D, WSP(f16, WS_WBR), D, 0, scr, r, F.lane); continue; } r -= I_BR;
        if (r < I_BR) { transpose_item(F.in[20] + (size_t)l * RW * D, RW, D, WSP(f16, WS_WBR), D, 512, scr, r, F.lane); continue; } r -= I_BR;
        if (r < I_OUT) { transpose_item(F.in[21] + (size_t)l * D * D, D, D, WSP(f16, WS_WOUT), D, 0, scr, r, F.lane); continue; } r -= I_OUT;
        if (r < I_UP) { transpose_item(F.in[24] + (size_t)l * D * FF, D, FF, WSP(f16, WS_WUP), D, 0, scr, r, F.lane); continue; } r -= I_UP;
        transpose_item(F.in[25] + (size_t)l * FF * D, FF, D, WSP(f16, WS_WDN), FF, 0, scr, r, F.lane);
    }
}
__device__ __forceinline__ void prologue(Frame& F, const double* invf) {
    convert_layer_weights(F, 0);
    LAS float* scr = (LAS float*)(F.lds + F.wave * 16384);
    constexpr int I_D = (64 / 64) * (RW / 32), I_G = (128 / 64) * (RW / 32), NL = 2 * I_D + I_G;
    for (int it = F.gw; it < DEPTH * NL; it += F.NGW) {
        const int l = it / NL; int r = it % NL; f16* base = (f16*)(F.ws + WS_LORA + (size_t)l * LORA_STRIDE);
        if (r < I_D) { transpose_item(F.in[9] + (size_t)l * 64 * RW, 64, RW, base, 64, 0, scr, r, F.lane); continue; } r -= I_D;
        if (r < I_D) { transpose_item(F.in[11] + (size_t)l * 64 * RW, 64, RW, base + 512 * 64, 64, 0, scr, r, F.lane); continue; } r -= I_D;
        transpose_item(F.in[12] + (size_t)l * 128 * RW, 128, RW, base + 2 * 512 * 64, 128, 0, scr, r, F.lane);
    }
    const size_t gt = (size_t)F.bid * NTHR + F.tid, NT = (size_t)F.G * NTHR;
    for (size_t i = gt; i < (size_t)M * D / 8; i += NT) {
        const size_t e = i * 8; const float* src = e < (size_t)MP * D ? F.in[0] + e : F.in[1] + (e - (size_t)MP * D);
        const f32x4 a = *(const f32x4*)src, b = *(const f32x4*)(src + 4);
        f16x8 o; o[0] = (f16)a.x; o[1] = (f16)a.y; o[2] = (f16)a.z; o[3] = (f16)a.w; o[4] = (f16)b.x; o[5] = (f16)b.y; o[6] = (f16)b.z; o[7] = (f16)b.w;
        *(f16x8*)(WSP(f16, WS_XH) + e) = o;
    }
    f32x2* rope = WSP(f32x2, WS_ROPE);
    for (size_t i = gt; i < (size_t)(PAST + DECT) * 32; i += NT) {
        const int pos = (int)(i >> 5), d = (int)(i & 31);
        const double ang = (double)pos * invf[d];
        const double n = __builtin_rint(ang * 0.63661977236758134308);
        double r = __builtin_fma(-n, 1.57079632679489655800e+00, ang); r = __builtin_fma(-n, 6.12323399573676603587e-17, r);
        const double r2 = r * r;
        double s = -2.50521083854417187751e-08; s = s * r2 + 2.75573192239858906526e-06; s = s * r2 - 1.98412698412698412698e-04; s = s * r2 + 8.33333333333333333333e-03; s = s * r2 - 1.66666666666666666667e-01; s = r + r * r2 * s;
        double c = 2.08767569878680989792e-09; c = c * r2 - 2.75573192239858906526e-07; c = c * r2 + 2.48015873015873015873e-05; c = c * r2 - 1.38888888888888888889e-03; c = c * r2 + 4.16666666666666666667e-02; c = c * r2 - 0.5; c = 1.0 + c * r2;
        const int q = ((int)n) & 3;
        const double cc = (q == 0) ? c : (q == 1) ? -s : (q == 2) ? -c : s;
        const double ss = (q == 0) ? s : (q == 1) ? c : (q == 2) ? -s : -c;
        rope[i] = (f32x2){(float)cc, (float)ss};
    }
}
__device__ __forceinline__ void ln_rows(Frame& F, const float* __restrict__ g, const float* __restrict__ b, bool final_out) {
    f16* XH = WSP(f16, WS_XH);
    const f32x4 g0 = *(const f32x4*)(g + F.lane * 8), g1 = *(const f32x4*)(g + F.lane * 8 + 4), g2 = *(const f32x4*)(g + 512 + F.lane * 8), g3 = *(const f32x4*)(g + 512 + F.lane * 8 + 4);
    const f32x4 b0 = *(const f32x4*)(b + F.lane * 8), b1 = *(const f32x4*)(b + F.lane * 8 + 4), b2 = *(const f32x4*)(b + 512 + F.lane * 8), b3 = *(const f32x4*)(b + 512 + F.lane * 8 + 4);
    for (int row = F.gw; row < M; row += F.NGW) {
        f16* p = XH + (size_t)row * D + F.lane * 8;
        const f16x8 h0 = *(const f16x8*)p, h1 = *(const f16x8*)(p + 512);
        f32x4 v0 = (f32x4){(float)h0[0], (float)h0[1], (float)h0[2], (float)h0[3]}, v1 = (f32x4){(float)h0[4], (float)h0[5], (float)h0[6], (float)h0[7]};
        f32x4 v2 = (f32x4){(float)h1[0], (float)h1[1], (float)h1[2], (float)h1[3]}, v3 = (f32x4){(float)h1[4], (float)h1[5], (float)h1[6], (float)h1[7]};
        f32x4 sv = (v0 + v1) + (v2 + v3);
        const float mean = wave_sum((sv.x + sv.y) + (sv.z + sv.w)) * (1.f / D);
        v0 -= mean; v1 -= mean; v2 -= mean; v3 -= mean;
        f32x4 qv = (v0 * v0 + v1 * v1) + (v2 * v2 + v3 * v3);
        const float rstd = 1.f / sqrtf(wave_sum((qv.x + qv.y) + (qv.z + qv.w)) * (1.f / D) + LN_EPS);
        v0 = v0 * rstd * g0 + b0; v1 = v1 * rstd * g1 + b1; v2 = v2 * rstd * g2 + b2; v3 = v3 * rstd * g3 + b3;
        if (final_out) {
            float* o = (row < MP ? F.out + O_YP + (size_t)row * D : F.out + O_YS + (size_t)(row - MP) * D) + F.lane * 8;
            *(f32x4*)o = v0; *(f32x4*)(o + 4) = v1; *(f32x4*)(o + 512) = v2; *(f32x4*)(o + 516) = v3;
        } else {
            f16x8 o0, o1;
            o0[0] = (f16)v0.x; o0[1] = (f16)v0.y; o0[2] = (f16)v0.z; o0[3] = (f16)v0.w; o0[4] = (f16)v1.x; o0[5] = (f16)v1.y; o0[6] = (f16)v1.z; o0[7] = (f16)v1.w;
            o1[0] = (f16)v2.x; o1[1] = (f16)v2.y; o1[2] = (f16)v2.z; o1[3] = (f16)v2.w; o1[4] = (f16)v3.x; o1[5] = (f16)v3.y; o1[6] = (f16)v3.z; o1[7] = (f16)v3.w;
            *(f16x8*)p = o0; *(f16x8*)(p + 512) = o1;
        }
    }
}
template <class Fn>
__device__ __forceinline__ void sample_gemm(Frame& F, int gws, const f16* A, int lda, const f16* Bt, int ldb, int K, int ncg, const Fn& f) {
    for (int task = gws; task < (MS / 32) * ncg; task += F.NGW)
        small_tile(A, lda, Bt, ldb, K, MP + 32 * (task % (MS / 32)), 64 * (task / (MS / 32)), 0, f, F.lane);
}

constexpr int AT_KS = 72, AT_VS = 264;
constexpr int AT_KOFF = 0, AT_VOFF = 256 * AT_KS * 2;
__device__ __forceinline__ void attn_prompt_unit(Frame& F, int l, int unit) {
    const int g = unit & 1, qb = (unit >> 1) & 63, b = unit >> 7;
    const int R0 = b * SEQ + 128 * qb;
    f16* YRA = WSP(f16, WS_YRA); const f16* KB = WSP(f16, WS_KB); const f16* VB = WSP(f16, WS_VB);
    LAS f16* Ks = (LAS f16*)(F.lds + AT_KOFF); LAS f16* Vt = (LAS f16*)(F.lds + AT_VOFF);
    __syncthreads();
#pragma unroll
    for (int i = 0; i < 4; ++i) {
        const int idx = F.tid + 512 * i, key = idx >> 3, ch = idx & 7;
        f16x8 kv, vv;
        if (qb == 0 && key < 128) { for (int e = 0; e < 8; ++e) { kv[e] = (f16)0.f; vv[e] = (f16)0.f; } }
        else { const size_t ro = (size_t)(R0 - 128 + key) * 128 + g * 64 + 8 * ch; kv = *(const f16x8*)(KB + ro); vv = *(const f16x8*)(VB + ro); }
        *(LAS f16x8*)(Ks + key * AT_KS + 8 * ch) = kv;
#pragma unroll
        for (int e = 0; e < 8; ++e) Vt[(8 * ch + e) * AT_VS + key] = vv[e];
    }
    __syncthreads();
    const int lane = F.lane, ql = lane & 31, h = lane >> 5;
    for (int s2 = 0; s2 < 2; ++s2) {
        const int task = F.wave * 2 + s2, hh = task >> 2, sb = task & 3, head = 4 * g + hh;
        f16* qrow = YRA + (size_t)(R0 + 32 * sb + ql) * D + 512 + head * 64;
        f16x8 qf[4];
#pragma unroll
        for (int kk = 0; kk < 4; ++kk) qf[kk] = *(const f16x8*)(qrow + 16 * kk + 8 * h);
        const float sink = F.in[18][l * 8 + head];
        f32x16 sc[5];
#pragma unroll
        for (int kt = 0; kt < 5; ++kt) {
#pragma unroll
            for (int i = 0; i < 16; ++i) sc[kt][i] = 0.f;
            const LAS f16* kp = Ks + (32 * (sb + kt) + ql) * AT_KS + 8 * h;
#pragma unroll
            for (int kk = 0; kk < 4; ++kk) sc[kt] = __builtin_amdgcn_mfma_f32_32x32x16_f16(*(const LAS f16x8*)(kp + 16 * kk), qf[kk], sc[kt], 0, 0, 0);
        }
        float mx = sink;
#pragma unroll
        for (int kt = 0; kt < 5; ++kt) {
            const bool tile_ok = (qb > 0) || (sb + kt >= 4);
#pragma unroll
            for (int r = 0; r < 16; ++r) {
                const int kl = (r & 3) + 8 * (r >> 2) + 4 * h;
                bool ok = tile_ok; if (kt == 0) ok = ok && (kl >= ql); if (kt == 4) ok = ok && (kl <= ql);
                sc[kt][r] = ok ? sc[kt][r] : -INFINITY;
                mx = fmaxf(mx, sc[kt][r]);
            }
        }
        mx = fmaxf(mx, __shfl_xor(mx, 32));
        float sum = 0.f;
#pragma unroll
        for (int kt = 0; kt < 5; ++kt)
#pragma unroll
            for (int r = 0; r < 16; ++r) { const float p = __expf(sc[kt][r] - mx); sc[kt][r] = p; sum += p; }
        sum += __shfl_xor(sum, 32);
        const float inv = rcpf_(sum + __expf(sink - mx));
        f32x16 o0, o1;
#pragma unroll
        for (int i = 0; i < 16; ++i) { o0[i] = 0.f; o1[i] = 0.f; }
#pragma unroll
        for (int kt = 0; kt < 5; ++kt)
#pragma unroll
            for (int s = 0; s < 2; ++s) {
                f16x8 pf;
#pragma unroll
                for (int j = 0; j < 8; ++j) pf[j] = (f16)(sc[kt][8 * s + j] * inv);
                const int kc = 32 * (sb + kt) + 16 * s + 4 * h;
                const LAS f16* v0p = Vt + ql * AT_VS + kc; const LAS f16* v1p = v0p + 32 * AT_VS;
                const f16x4 a0 = *(const LAS f16x4*)v0p, a1 = *(const LAS f16x4*)(v0p + 8), c0 = *(const LAS f16x4*)v1p, c1 = *(const LAS f16x4*)(v1p + 8);
                const f16x8 vf0 = (f16x8){a0.x, a0.y, a0.z, a0.w, a1.x, a1.y, a1.z, a1.w}, vf1 = (f16x8){c0.x, c0.y, c0.z, c0.w, c1.x, c1.y, c1.z, c1.w};
                o0 = __builtin_amdgcn_mfma_f32_32x32x16_f16(vf0, pf, o0, 0, 0, 0);
                o1 = __builtin_amdgcn_mfma_f32_32x32x16_f16(vf1, pf, o1, 0, 0, 0);
            }
#pragma unroll
        for (int gq = 0; gq < 4; ++gq) {
            *(f16x4*)(qrow + 8 * gq + 4 * h) = cvt4((f32x4){o0[4 * gq], o0[4 * gq + 1], o0[4 * gq + 2], o0[4 * gq + 3]});
            *(f16x4*)(qrow + 32 + 8 * gq + 4 * h) = cvt4((f32x4){o1[4 * gq], o1[4 * gq + 1], o1[4 * gq + 2], o1[4 * gq + 3]});
        }
    }
}
__device__ __forceinline__ void attn_sample_task(Frame& F, int l, int task) {
    const int g = task & 1, b = task >> 1, lane = F.lane, ql = lane & 31, h = lane >> 5;
    f16* YRA = WSP(f16, WS_YRA); const f16* KB = WSP(f16, WS_KB); const f16* VB = WSP(f16, WS_VB);
    const float* ck = F.in[4] + ((size_t)l * DECB + b) * WBUF * 128 + g * 64; const float* cv = F.in[5] + ((size_t)l * DECB + b) * WBUF * 128 + g * 64;
    const int rr = ql & 15, qi = rr >> 2, head = 4 * g + (rr & 3);
    f16* qrow = YRA + (size_t)(MP + 4 * b + qi) * D + 512 + head * 64;
    f16x8 qf[4];
#pragma unroll
    for (int kk = 0; kk < 4; ++kk) qf[kk] = *(const f16x8*)(qrow + 16 * kk + 8 * h);
    const float sink = F.in[18][l * 8 + head];
    f32x16 sc[5];
#pragma unroll
    for (int kt = 0; kt < 5; ++kt) {
#pragma unroll
        for (int i = 0; i < 16; ++i) sc[kt][i] = 0.f;
        const int key = 32 * kt + ql;
#pragma unroll
        for (int kk = 0; kk < 4; ++kk) {
            f16x8 kf;
            if (key < WBUF) { const f32x4 a = *(const f32x4*)(ck + (size_t)key * 128 + 16 * kk + 8 * h), c2 = *(const f32x4*)(ck + (size_t)key * 128 + 16 * kk + 8 * h + 4);
                kf = (f16x8){(f16)a.x, (f16)a.y, (f16)a.z, (f16)a.w, (f16)c2.x, (f16)c2.y, (f16)c2.z, (f16)c2.w}; }
            else if (key < WBUF + DECT) kf = *(const f16x8*)(KB + (size_t)(MP + 4 * b + key - WBUF) * 128 + g * 64 + 16 * kk + 8 * h);
            else kf = (f16x8){(f16)0.f, (f16)0.f, (f16)0.f, (f16)0.f, (f16)0.f, (f16)0.f, (f16)0.f, (f16)0.f};
            sc[kt] = __builtin_amdgcn_mfma_f32_32x32x16_f16(kf, qf[kk], sc[kt], 0, 0, 0);
        }
    }
    float mx = sink;
#pragma unroll
    for (int kt = 0; kt < 5; ++kt)
#pragma unroll
        for (int r = 0; r < 16; ++r) {
            const int key = 32 * kt + (r & 3) + 8 * (r >> 2) + 4 * h;
            const bool ok = key < WBUF ? (key >= qi) : (key < WBUF + DECT && key - WBUF <= qi);
            sc[kt][r] = ok ? sc[kt][r] : -INFINITY; mx = fmaxf(mx, sc[kt][r]);
        }
    mx = fmaxf(mx, __shfl_xor(mx, 32));
    float sum = 0.f;
#pragma unroll
    for (int kt = 0; kt < 5; ++kt)
#pragma unroll
        for (int r = 0; r < 16; ++r) { const float p = __expf(sc[kt][r] - mx); sc[kt][r] = p; sum += p; }
    sum += __shfl_xor(sum, 32);
    const float inv = rcpf_(sum + __expf(sink - mx));
    f32x16 o0, o1;
#pragma unroll
    for (int i = 0; i < 16; ++i) { o0[i] = 0.f; o1[i] = 0.f; }
#pragma unroll
    for (int kt = 0; kt < 5; ++kt)
#pragma unroll
        for (int s = 0; s < 2; ++s) {
            f16x8 pf, vf0, vf1;
#pragma unroll
            for (int j = 0; j < 8; ++j) {
                pf[j] = (f16)(sc[kt][8 * s + j] * inv);
                const int key = 32 * kt + 16 * s + 8 * (j >> 2) + 4 * h + (j & 3);
                float x0 = 0.f, x1 = 0.f;
                if (key < WBUF) { x0 = cv[(size_t)key * 128 + ql]; x1 = cv[(size_t)key * 128 + 32 + ql]; }
                else if (key < WBUF + DECT) { const f16* vp = VB + (size_t)(MP + 4 * b + key - WBUF) * 128 + g * 64; x0 = (float)vp[ql]; x1 = (float)vp[32 + ql]; }
                vf0[j] = (f16)x0; vf1[j] = (f16)x1;
            }
            o0 = __builtin_amdgcn_mfma_f32_32x32x16_f16(vf0, pf, o0, 0, 0, 0);
            o1 = __builtin_amdgcn_mfma_f32_32x32x16_f16(vf1, pf, o1, 0, 0, 0);
        }
    if (ql < 16) {
#pragma unroll
        for (int gq = 0; gq < 4; ++gq) {
            *(f16x4*)(qrow + 8 * gq + 4 * h) = cvt4((f32x4){o0[4 * gq], o0[4 * gq + 1], o0[4 * gq + 2], o0[4 * gq + 3]});
            *(f16x4*)(qrow + 32 + 8 * gq + 4 * h) = cvt4((f32x4){o1[4 * gq], o1[4 * gq + 1], o1[4 * gq + 2], o1[4 * gq + 3]});
        }
    }
}

template <int T> struct RL { static constexpr int W = 0, AL = T * 256, BE = 2 * T * 256, R = 3 * T * 256, KP = R + T * 128, V = KP + T * 128, SIZE = V + T * 128; };
constexpr int SH_P = 264, RAW_OFF = 8 * RL<8>::SIZE, RAW_SZ = 32768, SHP_OFF = RAW_OFF + 2 * RAW_SZ, SHS_OFF = 8 * RL<16>::SIZE;
constexpr int PRM_OFF = SHP_OFF + 8 * SH_P * 2, PR_DB = 0, PR_MU = 2048, PR_IB = PR_MU + 3584, PR_KK = PR_IB + 1024, PR_KA = PR_KK + 1024, PR_RK = PR_KA + 1024, PRM_SZ = PR_RK + 1024;
static_assert(PRM_OFF + PRM_SZ <= MISC_OFF && SHS_OFF + 16 * SH_P * 2 <= MISC_OFF, "scan LDS map");
#define CFENCE() asm volatile("" ::: "memory")
struct RwkvP { const f16* ZR; f16* YRA; f16* GG; const f16* lora; const float *mu, *dbase, *ibase, *kk_, *ka_, *rk_, *sshift; };
__device__ __forceinline__ RwkvP rwkv_params(Frame& F, int l) {
    RwkvP P; P.ZR = WSP(f16, WS_ZR); P.YRA = WSP(f16, WS_YRA); P.GG = WSP(f16, WS_GG); P.lora = (const f16*)(F.ws + WS_LORA + (size_t)l * LORA_STRIDE);
    P.mu = F.in[7] + (size_t)l * SHW; P.dbase = F.in[8] + (size_t)l * RW; P.ibase = F.in[10] + (size_t)l * RW; P.kk_ = F.in[13] + (size_t)l * RW; P.ka_ = F.in[14] + (size_t)l * RW;
    P.rk_ = F.in[15] + (size_t)l * RW; P.sshift = F.in[3] + (size_t)l * DECB * SHW; return P;
}
template <bool SAMPLE>
__device__ __forceinline__ f32x4 par4(const float* g, const LAS unsigned char* prm, int off, int i) {
    if (SAMPLE) return *(const f32x4*)(g + i);
    return up4(*(const LAS f16x4*)(prm + off + 2 * i));
}
template <bool SAMPLE>
__device__ __forceinline__ f32x4 zs4(const RwkvP& P, const LAS f16* raw, const LAS unsigned char* prm, int row, int tl, int col) {
    f32x4 z, pv;
    if (SAMPLE) {
        z = up4(*(const f16x4*)(P.ZR + (size_t)row * SHW + col));
        if (((row - MP) & 3) == 0) pv = *(const f32x4*)(P.sshift + (size_t)((row - MP) >> 2) * SHW + col); else pv = up4(*(const f16x4*)(P.ZR + (size_t)(row - 1) * SHW + col));
    } else {
        z = up4(*(const LAS f16x4*)(raw + (tl + 1) * SHW + col));
        pv = up4(*(const LAS f16x4*)(raw + tl * SHW + col));
        if ((row & (SEQ - 1)) == 0) pv = (f32x4){0.f, 0.f, 0.f, 0.f};
    }
    f32x4 m;
    if (SAMPLE) m = *(const f32x4*)(P.mu + col); else m = up4(*(const LAS f16x4*)(prm + PR_MU + 2 * col));
    return z + (pv - z) * m;
}
__device__ __forceinline__ float lora_act(float x, int col) {
    const float sc = col < 64 ? 2.0f : 1.0f, cc = col < 64 ? -1.0f : 0.0f;
    const float y = sc * rcpf_(1.0f + __expf(-sc * x)) + cc;
    return (col >= 64 && col < 128) ? x : y;
}
template <bool SAMPLE>
__device__ __forceinline__ void rwkv_prepA(const RwkvP& P, int wave, int row0, const LAS f16* raw, const LAS unsigned char* prm, LAS f16* sh, int lane) {
    if (SAMPLE) {
        const int tk = 2 * wave + (lane >> 5), c8 = 8 * (lane & 31), row = row0 + tk;
        const f32x4 a = zs4<true>(P, raw, prm, row, tk, 3 * RW + c8), b = zs4<true>(P, raw, prm, row, tk, 3 * RW + c8 + 4);
        f16x8 o;
#pragma unroll
        for (int e = 0; e < 8; ++e) o[e] = (f16)lora_act(e < 4 ? a[e & 3] : b[e & 3], c8);
        *(LAS f16x8*)(sh + tk * SH_P + c8) = o;
    } else {
        const int tk = wave, c4 = 4 * lane, row = row0 + tk;
        const f32x4 a = zs4<false>(P, raw, prm, row, tk, 3 * RW + c4);
        f16x4 o;
#pragma unroll
        for (int e = 0; e < 4; ++e) o[e] = (f16)lora_act(a[e], c4);
        *(LAS f16x4*)(sh + tk * SH_P + c4) = o;
    }
}
template <bool SAMPLE, int T>
__device__ __forceinline__ void rwkv_prepB(const RwkvP& P, int h, int row0, const LAS f16* raw, const LAS unsigned char* prm, const LAS f16* shb, LAS unsigned char* wl, int lane) {
    typedef RL<T> L;
    const int tl = (lane & 15) & (T - 1), q = lane >> 4, row = row0 + tl;
    const bool st = SAMPLE || ((lane & 15) < T);
    const f16* DU = P.lora + (size_t)(h * 64 + (lane & 15)) * 64 + 8 * q; const f16* IU = DU + 512 * 64; const f16* GU = P.lora + 2 * 512 * 64 + (size_t)(h * 64 + (lane & 15)) * 128 + 8 * q;
    const LAS f16* sh = shb + tl * SH_P + 8 * q;
    f32x4 acc[4];
#pragma unroll
    for (int nt = 0; nt < 4; ++nt) acc[nt] = (f32x4){0.f, 0.f, 0.f, 0.f};
#pragma unroll
    for (int kk = 0; kk < 2; ++kk) { const f16x8 fr = *(const LAS f16x8*)(sh + 32 * kk);
#pragma unroll
        for (int nt = 0; nt < 4; ++nt) acc[nt] = __builtin_amdgcn_mfma_f32_16x16x32_f16(*(const f16x8*)(DU + (size_t)nt * 16 * 64 + 32 * kk), fr, acc[nt], 0, 0, 0); }
#pragma unroll
    for (int nt = 0; nt < 4; ++nt) {
        const int c4 = 16 * nt + 4 * q;
        const f32x4 sg = sig4((SAMPLE ? *(const f32x4*)(P.dbase + h * 64 + c4) : *(const LAS f32x4*)(prm + PR_DB + 4 * (h * 64 + c4))) + acc[nt]);
        f32x4 w; w.x = __expf(-0.60653065971263342f * sg.x); w.y = __expf(-0.60653065971263342f * sg.y); w.z = __expf(-0.60653065971263342f * sg.z); w.w = __expf(-0.60653065971263342f * sg.w);
        if (st) *(LAS f32x4*)(wl + L::W + (tl * 64 + c4) * 4) = w;
    }
    CFENCE();
    if (SAMPLE) {
#pragma unroll
        for (int nt = 0; nt < 4; ++nt) acc[nt] = (f32x4){0.f, 0.f, 0.f, 0.f};
#pragma unroll
        for (int kk = 0; kk < 4; ++kk) { const f16x8 fr = *(const LAS f16x8*)(sh + 128 + 32 * kk);
#pragma unroll
            for (int nt = 0; nt < 4; ++nt) acc[nt] = __builtin_amdgcn_mfma_f32_16x16x32_f16(*(const f16x8*)(GU + (size_t)nt * 16 * 128 + 32 * kk), fr, acc[nt], 0, 0, 0); }
#pragma unroll
        for (int nt = 0; nt < 4; ++nt) *(f16x4*)(P.GG + (size_t)(row - MP) * RW + h * 64 + 16 * nt + 4 * q) = cvt4(acc[nt]);
        CFENCE();
    }
#pragma unroll
    for (int nt = 0; nt < 4; ++nt) acc[nt] = (f32x4){0.f, 0.f, 0.f, 0.f};
#pragma unroll
    for (int kk = 0; kk < 2; ++kk) { const f16x8 fr = *(const LAS f16x8*)(sh + 64 + 32 * kk);
#pragma unroll
        for (int nt = 0; nt < 4; ++nt) acc[nt] = __builtin_amdgcn_mfma_f32_16x16x32_f16(*(const f16x8*)(IU + (size_t)nt * 16 * 64 + 32 * kk), fr, acc[nt], 0, 0, 0); }
    float ssq = 0.f, bon = 0.f;
#pragma unroll
    for (int nt = 0; nt < 4; ++nt) {
        const int c4 = 16 * nt + 4 * q, ch = h * 64 + c4;
        const f32x4 av = sig4(par4<SAMPLE>(P.ibase, prm, PR_IB, ch) + acc[nt]);
        const f32x4 rv = zs4<SAMPLE>(P, raw, prm, row, tl, ch), kx = zs4<SAMPLE>(P, raw, prm, row, tl, RW + ch), vv = zs4<SAMPLE>(P, raw, prm, row, tl, 2 * RW + ch);
        const f32x4 kkv = kx * par4<SAMPLE>(P.kk_, prm, PR_KK, ch);
        const f32x4 kp = kx * (1.0f + (av - 1.0f) * par4<SAMPLE>(P.ka_, prm, PR_KA, ch));
        const f32x4 s2 = kkv * kkv; ssq += (s2.x + s2.y) + (s2.z + s2.w);
        const f32x4 b2 = rv * kp * par4<SAMPLE>(P.rk_, prm, PR_RK, ch); bon += (b2.x + b2.y) + (b2.z + b2.w);
        if (st) {
            *(LAS f32x4*)(wl + L::AL + (tl * 64 + c4) * 4) = kkv;
            *(LAS f32x4*)(wl + L::BE + (tl * 64 + c4) * 4) = av;
            *(LAS f16x4*)(wl + L::R + (tl * 64 + c4) * 2) = cvt4(rv);
            *(LAS f16x4*)(wl + L::KP + (tl * 64 + c4) * 2) = cvt4(kp);
            *(LAS f16x4*)(wl + L::V + (tl * 64 + c4) * 2) = cvt4(vv);
        }
        CFENCE();
    }
    ssq += __shfl_xor(ssq, 16); ssq += __shfl_xor(ssq, 32); bon += __shfl_xor(bon, 16); bon += __shfl_xor(bon, 32);
    const float inv = rsqf_(fmaxf(ssq, 1e-24f));
    LDS_WAIT();
    if (st) {
#pragma unroll
        for (int nt = 0; nt < 4; ++nt) {
            const int c4 = 16 * nt + 4 * q;
            const f32x4 kn = *(const LAS f32x4*)(wl + L::AL + (tl * 64 + c4) * 4) * inv, av = *(const LAS f32x4*)(wl + L::BE + (tl * 64 + c4) * 4);
            *(LAS f32x4*)(wl + L::AL + (tl * 64 + c4) * 4) = -kn;
            *(LAS f32x4*)(wl + L::BE + (tl * 64 + c4) * 4) = kn * av;
            const f32x4 vv = up4(*(const LAS f16x4*)(wl + L::V + (tl * 64 + c4) * 2));
            *(f16x4*)(P.YRA + (size_t)row * D + h * 64 + c4) = cvt4(vv * bon);
        }
    }
    CFENCE();
}
template <bool HAS_P, int T>
__device__ __forceinline__ void scan_step(float (&SP)[64], float (&SU)[64], const LAS unsigned char* wl, int t, float vv, float& yp, float& yu) {
    typedef RL<T> L;
    const LAS unsigned char* pa = wl + L::AL + t * 256; const LAS unsigned char* pw = wl + L::W + t * 256; const LAS unsigned char* pb = wl + L::BE + t * 256;
    const LAS unsigned char* pr = wl + L::R + t * 128; const LAS unsigned char* pk = wl + L::KP + t * 128;
    float saP = 0.f, saU = 0.f;
    f32x4 A0 = *(const LAS f32x4*)(pa);
#pragma unroll
    for (int g = 0; g < 16; ++g) {
        f32x4 N0 = A0;
        if (g < 15) N0 = *(const LAS f32x4*)(pa + 16 * (g + 1));
#pragma unroll
        for (int e = 0; e < 4; ++e) { saU = fmaf(SU[4 * g + e], A0[e], saU); if (HAS_P) saP = fmaf(SP[4 * g + e], A0[e], saP); }
        A0 = N0;
        CFENCE();
    }
    float yP = 0.f, yU = 0.f;
    f32x4 W0 = *(const LAS f32x4*)(pw), B0 = *(const LAS f32x4*)(pb);
    f16x4 R = *(const LAS f16x4*)(pr), K = *(const LAS f16x4*)(pk);
#pragma unroll
    for (int g = 0; g < 16; ++g) {
        f32x4 nW0 = W0, nB0 = B0; f16x4 nR = R, nK = K;
        if (g < 15) { nW0 = *(const LAS f32x4*)(pw + 16 * (g + 1)); nB0 = *(const LAS f32x4*)(pb + 16 * (g + 1)); nR = *(const LAS f16x4*)(pr + 8 * (g + 1)); nK = *(const LAS f16x4*)(pk + 8 * (g + 1)); }
#pragma unroll
        for (int e = 0; e < 4; ++e) {
            const int k = 4 * g + e;
            float u = fmaf(vv, (float)K[e], B0[e] * saU);
            SU[k] = fmaf(SU[k], W0[e], u);
            yU = fmaf(SU[k], (float)R[e], yU);
            if (HAS_P) { SP[k] = fmaf(SP[k], W0[e], B0[e] * saP); yP = fmaf(SP[k], (float)R[e], yP); }
        }
        W0 = nW0; B0 = nB0; R = nR; K = nK;
        CFENCE();
    }
    yp = yP; yu = yU;
}
__device__ __forceinline__ void scan_stage(const f16* ZR, int rowm1, LAS unsigned char* dst, int wave, int lane) {
    const char* g = (const char*)(ZR + (ptrdiff_t)rowm1 * SHW);
#pragma unroll
    for (int i = 0; i < 4; ++i) { const int blk = i * 8 + wave;
        __builtin_amdgcn_global_load_lds((const unsigned*)(g + (blk * 64 + lane) * 16), (LAS unsigned*)(dst + blk * 1024), 16, 0, 0); }
}
__device__ __forceinline__ void scan_unit_prompt(Frame& F, int l, int unit) {
    typedef RL<8> L;
    const int h = F.wave, lane = F.lane;
    const RwkvP P = rwkv_params(F, l);
    LAS unsigned char* wl = F.lds + h * L::SIZE;
    LAS f16* sh = (LAS f16*)(F.lds + SHP_OFF);
    const int row0 = (unit >> 7) * SEQ + (unit & 127) * CH;
    f16* ysc = (f16*)(F.ws + WS_YSC) + ((size_t)unit * 8 + h) * 8192;
    const LAS unsigned char* prm = F.lds + PRM_OFF;
    __syncthreads();
    {
        LAS unsigned char* pw_ = F.lds + PRM_OFF; const int t4 = 4 * F.tid;
        if (t4 < RW) { *(LAS f32x4*)(pw_ + PR_DB + 4 * t4) = *(const f32x4*)(P.dbase + t4); *(LAS f16x4*)(pw_ + PR_IB + 2 * t4) = cvt4(*(const f32x4*)(P.ibase + t4)); *(LAS f16x4*)(pw_ + PR_KK + 2 * t4) = cvt4(*(const f32x4*)(P.kk_ + t4));
                       *(LAS f16x4*)(pw_ + PR_KA + 2 * t4) = cvt4(*(const f32x4*)(P.ka_ + t4)); *(LAS f16x4*)(pw_ + PR_RK + 2 * t4) = cvt4(*(const f32x4*)(P.rk_ + t4)); }
        if (t4 < SHW) *(LAS f16x4*)(pw_ + PR_MU + 2 * t4) = cvt4(*(const f32x4*)(P.mu + t4));
    }
    scan_stage(P.ZR, row0 - 1, F.lds + RAW_OFF, h, lane);
    VM_WAIT(); LDS_WAIT(); __syncthreads();
    float SP[64], SU[64];
    { int l0 = lane; asm volatile("" : "+v"(l0));
#pragma unroll
      for (int k = 0; k < 64; ++k) { SP[k] = (k == l0) ? 1.f : 0.f; SU[k] = 0.f; } }
    for (int g = 0; g < 8; ++g) {
        const LAS f16* raw = (const LAS f16*)(F.lds + RAW_OFF + (g & 1) * RAW_SZ);
        int lz = lane; asm volatile("" : "+v"(lz));
        rwkv_prepA<false>(P, h, row0 + 8 * g, raw, prm, sh, lz);
        LDS_WAIT(); __syncthreads();
        if (g < 7) scan_stage(P.ZR, row0 + 8 * (g + 1) - 1, F.lds + RAW_OFF + ((g + 1) & 1) * RAW_SZ, h, lz);
        rwkv_prepB<false, 8>(P, h, row0 + 8 * g, raw, prm, sh, wl, lz);
        LDS_WAIT();
        for (int t = 0; t < 8; ++t) {
            const float vv = (float)*(const LAS f16*)(wl + L::V + (t * 64 + lz) * 2);
            float yp, yu; scan_step<true, 8>(SP, SU, wl, t, vv, yp, yu);
            ysc[(8 * g + t) * 64 + lz] = (f16)yp;
            ysc[4096 + (8 * g + t) * 64 + lz] = (f16)yu;
        }
        VM_WAIT(); __syncthreads();
    }
    float* pu = F.out + ((size_t)unit * 8 + h) * 8192 + lane * 64;
#pragma unroll
    for (int k = 0; k < 16; ++k) { *(f32x4*)(pu + 4 * k) = (f32x4){SP[4 * k], SP[4 * k + 1], SP[4 * k + 2], SP[4 * k + 3]}; *(f32x4*)(pu + 4096 + 4 * k) = (f32x4){SU[4 * k], SU[4 * k + 1], SU[4 * k + 2], SU[4 * k + 3]}; }
}
__device__ __forceinline__ void scan_unit_sample(Frame& F, int l, int unit) {
    typedef RL<16> L;
    int lane = F.lane; asm volatile("" : "+v"(lane));
    const int h = F.wave;
    const RwkvP P = rwkv_params(F, l);
    LAS unsigned char* wl = F.lds + h * L::SIZE;
    LAS f16* sh = (LAS f16*)(F.lds + SHS_OFF);
    const int row0 = MP + 16 * unit;
    __syncthreads();
    rwkv_prepA<true>(P, h, row0, nullptr, nullptr, sh, lane);
    LDS_WAIT(); __syncthreads();
    rwkv_prepB<true, 16>(P, h, row0, nullptr, nullptr, sh, wl, lane);
    LDS_WAIT(); VM_WAIT(); __syncthreads();
    const float lg = F.in[16][l * RW + h * 64 + lane], lb = F.in[17][l * RW + h * 64 + lane];
    for (int bb = 0; bb < 4; ++bb) {
        const int b = 4 * unit + bb;
        float S[64];
        const float* s0 = F.in[2] + (((size_t)l * DECB + b) * 8 + h) * 4096 + lane * 64;
#pragma unroll
        for (int k = 0; k < 16; ++k) { const f32x4 t4 = *(const f32x4*)(s0 + 4 * k); S[4 * k] = t4.x; S[4 * k + 1] = t4.y; S[4 * k + 2] = t4.z; S[4 * k + 3] = t4.w; }
        for (int t = 0; t < 4; ++t) {
            const int tt = 4 * bb + t, row = row0 + tt;
            const float vv = (float)*(const LAS f16*)(wl + L::V + (tt * 64 + lane) * 2);
            float ydummy, y; scan_step<false, 16>(S, S, wl, tt, vv, ydummy, y);
            const float mu = wave_sum(y) * (1.f / 64.f), dv = y - mu, var = wave_sum(dv * dv) * (1.f / 64.f);
            f16* yp = P.YRA + (size_t)row * D + h * 64 + lane;
            const float o = (dv * rsqf_(var + GN_EPS) * lg + lb + (float)*yp) * (float)P.GG[(size_t)(row - MP) * RW + h * 64 + lane];
            *yp = (f16)o;
        }
        float* so = F.out + O_SWKV + (((size_t)l * DECB + b) * 8 + h) * 4096 + lane * 64;
#pragma unroll
        for (int k = 0; k < 16; ++k) *(f32x4*)(so + 4 * k) = (f32x4){S[4 * k], S[4 * k + 1], S[4 * k + 2], S[4 * k + 3]};
    }
    LDS_WAIT();
}
__device__ __forceinline__ void spass_task(Frame& F, int l, int task) {
    const int w = task & 3, h = (task >> 2) & 7, b = task >> 5, lane = F.lane, m = lane & 15, q = lane >> 4;
    f32x4 X[4];
#pragma unroll
    for (int J = 0; J < 4; ++J) X[J] = (f32x4){0.f, 0.f, 0.f, 0.f};
    for (int c = 0; c < NCH; ++c) {
        float* pu = F.out + ((size_t)(b * NCH + c) * 8 + h) * 8192;
        const float* Pc = pu; float* Uc = pu + 4096 + (16 * w + m) * 64 + 4 * q;
        f32x4 Xn[4];
#pragma unroll
        for (int I = 0; I < 4; ++I) Xn[I] = *(const f32x4*)(Uc + 16 * I);
#pragma unroll
        for (int J = 0; J < 4; ++J)
#pragma unroll
            for (int kk = 0; kk < 4; ++kk) {
                const float* prow = Pc + (16 * J + 4 * q + kk) * 64 + m;
#pragma unroll
                for (int I = 0; I < 4; ++I) Xn[I] = __builtin_amdgcn_mfma_f32_16x16x4f32(prow[16 * I], X[J][kk], Xn[I], 0, 0, 0);
            }
#pragma unroll
        for (int I = 0; I < 4; ++I) { X[I] = Xn[I]; *(f32x4*)(Uc + 16 * I) = Xn[I]; }
    }
    float* so = F.out + O_PWKV + (((size_t)l * NB + b) * 8 + h) * 4096 + (16 * w + m) * 64 + 4 * q;
#pragma unroll
    for (int I = 0; I < 4; ++I) *(f32x4*)(so + 16 * I) = X[I];
}
constexpr int SG_P = 136;
__device__ __forceinline__ void combine_unit(Frame& F, int l, int unit) {
    const int h = F.wave, c = unit & 127, b = unit >> 7, lane = F.lane, ql = lane & 31, hf = lane >> 5;
    const int row0 = b * SEQ + c * CH;
    const f16* ZR = WSP(f16, WS_ZR);
    LAS f16* SG = (LAS f16*)F.lds;
    __syncthreads();
    {
        const int tk = F.tid >> 3, c16 = 3 * RW + 128 + 16 * (F.tid & 7), row = row0 + tk;
        const float* mu = F.in[7] + (size_t)l * SHW + c16;
#pragma unroll
        for (int hh = 0; hh < 2; ++hh) {
            const f16x8 z = *(const f16x8*)(ZR + (size_t)row * SHW + c16 + 8 * hh);
            f16x8 pv; if ((row & (SEQ - 1)) == 0) { for (int e = 0; e < 8; ++e) pv[e] = (f16)0.f; } else pv = *(const f16x8*)(ZR + (size_t)(row - 1) * SHW + c16 + 8 * hh);
            const f32x4 m0 = *(const f32x4*)(mu + 8 * hh), m1 = *(const f32x4*)(mu + 8 * hh + 4);
            f16x8 o;
#pragma unroll
            for (int e = 0; e < 8; ++e) { const float zz = (float)z[e], pp = (float)pv[e], mm = e < 4 ? m0[e & 3] : m1[e & 3]; o[e] = (f16)sigmoidf_(zz + (pp - zz) * mm); }
            *(LAS f16x8*)(SG + tk * SG_P + 16 * (F.tid & 7) + 8 * hh) = o;
        }
    }
    LDS_WAIT(); __syncthreads();
    const f16* ysc = (const f16*)(F.ws + WS_YSC) + ((size_t)unit * 8 + h) * 8192;
    f32x16 acc[2][2];
#pragma unroll
    for (int vt = 0; vt < 2; ++vt)
#pragma unroll
        for (int tt = 0; tt < 2; ++tt)
#pragma unroll
            for (int i = 0; i < 16; ++i) acc[vt][tt][i] = 0.f;
    if (c > 0) {
        const float* Sc = F.out + ((size_t)(unit - 1) * 8 + h) * 8192 + 4096;
#pragma unroll
        for (int kk = 0; kk < 4; ++kk) {
            f16x8 sf[2], yf[2];
#pragma unroll
            for (int vt = 0; vt < 2; ++vt) { const float* sp = Sc + (32 * vt + ql) * 64 + 16 * kk + 8 * hf; const f32x4 a = *(const f32x4*)sp, bq = *(const f32x4*)(sp + 4);
                sf[vt] = (f16x8){(f16)a.x, (f16)a.y, (f16)a.z, (f16)a.w, (f16)bq.x, (f16)bq.y, (f16)bq.z, (f16)bq.w}; }
#pragma unroll
            for (int tt = 0; tt < 2; ++tt) yf[tt] = *(const f16x8*)(ysc + (32 * tt + ql) * 64 + 16 * kk + 8 * hf);
#pragma unroll
            for (int vt = 0; vt < 2; ++vt)
#pragma unroll
                for (int tt = 0; tt < 2; ++tt) acc[vt][tt] = __builtin_amdgcn_mfma_f32_32x32x16_f16(sf[vt], yf[tt], acc[vt][tt], 0, 0, 0);
        }
    }
    f16* YRA = WSP(f16, WS_YRA);
    const f16* GU = (const f16*)(F.ws + WS_LORA + (size_t)l * LORA_STRIDE) + 2 * 512 * 64 + (size_t)(h * 64 + ql) * 128 + 8 * hf;
    const float* lg = F.in[16] + l * RW + h * 64; const float* lb = F.in[17] + l * RW + h * 64;
#pragma unroll
    for (int tt = 0; tt < 2; ++tt) {
        const int t = 32 * tt + ql, row = row0 + t;
        f32x16 gac[2];
#pragma unroll
        for (int vt = 0; vt < 2; ++vt)
#pragma unroll
            for (int i = 0; i < 16; ++i) gac[vt][i] = 0.f;
#pragma unroll
        for (int kk = 0; kk < 8; ++kk) {
            const f16x8 gf = *(const LAS f16x8*)(SG + t * SG_P + 16 * kk + 8 * hf);
#pragma unroll
            for (int vt = 0; vt < 2; ++vt) gac[vt] = __builtin_amdgcn_mfma_f32_32x32x16_f16(*(const f16x8*)(GU + (size_t)vt * 32 * 128 + 16 * kk), gf, gac[vt], 0, 0, 0);
        }
        float s = 0.f;
#pragma unroll
        for (int vt = 0; vt < 2; ++vt)
#pragma unroll
            for (int g4 = 0; g4 < 4; ++g4) { const f32x4 yu = up4(*(const f16x4*)(ysc + 4096 + t * 64 + 32 * vt + 8 * g4 + 4 * hf));
                acc[vt][tt][4 * g4] += yu.x; acc[vt][tt][4 * g4 + 1] += yu.y; acc[vt][tt][4 * g4 + 2] += yu.z; acc[vt][tt][4 * g4 + 3] += yu.w;
                s += (acc[vt][tt][4 * g4] + acc[vt][tt][4 * g4 + 1]) + (acc[vt][tt][4 * g4 + 2] + acc[vt][tt][4 * g4 + 3]); }
        s += __shfl_xor(s, 32);
        const float mu = s * (1.f / 64.f); float qv = 0.f;
#pragma unroll
        for (int vt = 0; vt < 2; ++vt)
#pragma unroll
            for (int i = 0; i < 16; ++i) { const float d = acc[vt][tt][i] - mu; qv += d * d; }
        qv += __shfl_xor(qv, 32);
        const float rstd = rsqf_(qv * (1.f / 64.f) + GN_EPS);
#pragma unroll
        for (int vt = 0; vt < 2; ++vt)
#pragma unroll
            for (int g4 = 0; g4 < 4; ++g4) {
                const int v = 32 * vt + 8 * g4 + 4 * hf;
                const f32x4 y = (f32x4){acc[vt][tt][4 * g4], acc[vt][tt][4 * g4 + 1], acc[vt][tt][4 * g4 + 2], acc[vt][tt][4 * g4 + 3]};
                const f32x4 gg = (f32x4){gac[vt][4 * g4], gac[vt][4 * g4 + 1], gac[vt][4 * g4 + 2], gac[vt][4 * g4 + 3]};
                f16* yp = YRA + (size_t)row * D + h * 64 + v;
                const f32x4 bv = up4(*(const f16x4*)yp);
                *(f16x4*)yp = cvt4(((y - mu) * rstd * *(const f32x4*)(lg + v) + *(const f32x4*)(lb + v) + bv) * gg);
            }
    }
}

#ifndef MK_PER_PHASE
#define MK_PER_PHASE 0
#endif
constexpr int NPHASE = 1 + DEPTH * 10;
struct KArgs { Args a; double invf[32]; };
__global__ void __launch_bounds__(NTHR, 2) mk_fwd(KArgs ka) {
    extern __shared__ __attribute__((aligned(16))) unsigned char lds_raw[];
    Frame F;
    F.lds = (LAS unsigned char*)lds_raw;
    F.tid = threadIdx.x; F.lane = F.tid & 63; F.wave = __builtin_amdgcn_readfirstlane(F.tid >> 6);
    F.G = gridDim.x; F.bid = blockIdx.x; F.gw = F.bid * NWAVES + F.wave; F.NGW = F.G * NWAVES;
    F.in = ka.a.in; F.out = ka.a.out; F.ws = ka.a.ws;
    volatile LAS unsigned* MISC = (volatile LAS unsigned*)(F.lds + MISC_OFF);
    if (F.tid < 64) MISC[F.tid] = 0u;
    __syncthreads();
    XcdBarrier bar = xcd_barrier_post((unsigned*)(F.ws + WS_CTL) + CW_BAR, MISC + 8);
    const int lo = ka.a.ph_lo, hi = ka.a.ph_hi;
    int ph = 0;
#define PHASE_BEGIN if (lo <= ph && ph < hi) { { int _t = threadIdx.x; asm volatile("" : "+v"(_t)); F.tid = _t; F.lane = _t & 63; \
        size_t _z = 0; int _b = blockIdx.x; asm volatile("" : "+s"(_z), "+s"(_b)); F.out = ka.a.out + _z; F.ws = ka.a.ws + _z; F.bid = _b; F.gw = _b * NWAVES + F.wave; }
#define PHASE_END   if (ph + 1 < hi) xcd_barrier(bar); } ++ph;

    PHASE_BEGIN prologue(F, ka.invf); PHASE_END

    for (int l = 0; l < DEPTH; ++l) {
        f16* XH = WSP(f16, WS_XH); f16* YRA = WSP(f16, WS_YRA); f16* MIX = WSP(f16, WS_MIX); f16* HB = WSP(f16, WS_H);
        const f16* WIN = WSP(f16, WS_WIN); const f16* WBR = WSP(f16, WS_WBR); const f16* WOUT = WSP(f16, WS_WOUT); const f16* WUP = WSP(f16, WS_WUP); const f16* WDN = WSP(f16, WS_WDN);
        PHASE_BEGIN {
            const EpiG1 e{WSP(f16, WS_ZR), YRA, WSP(f16, WS_KB), WSP(f16, WS_VB), WSP(f32x2, WS_ROPE), F.out, l};
            const SchedPlain S{XH, WIN, D, D, 10, 16, F.G, F.bid};
            pg8::gemm_phase(F.lds, D, D, S, EpiBig<EpiG1>{e}, F.tid);
            sample_gemm(F, ((F.bid + F.G / 2) % F.G) * NWAVES + F.wave, XH, D, WIN, D, D, OGR / 64, e);
        } PHASE_END
        PHASE_BEGIN {
            for (int u = F.bid; u < NB * NCH; u += F.G) scan_unit_prompt(F, l, u);
            __syncthreads();
            for (int u = F.bid; u < NB * 64 * 2; u += F.G) attn_prompt_unit(F, l, u);
            __syncthreads();
            for (int u = F.bid; u < MS / 16; u += F.G) scan_unit_sample(F, l, u);
            __syncthreads();
            for (int t = ((F.bid + F.G - 32) % F.G) * NWAVES + F.wave; t < DECB * 2; t += F.NGW) attn_sample_task(F, l, t);
            const size_t gt = (size_t)F.bid * NTHR + F.tid, NT = (size_t)F.G * NTHR; constexpr int PER = (WBUF - DECT) * 128 / 4;
            for (size_t i = gt; i < (size_t)2 * DECB * PER; i += NT) {
                const int kv = (int)(i / ((size_t)DECB * PER)), r = (int)(i % ((size_t)DECB * PER)), b = r / PER, e = (r % PER) * 4;
                const float* src = F.in[4 + kv] + ((size_t)l * DECB + b) * WBUF * 128 + DECT * 128 + e;
                float* dst = F.out + (kv ? O_SV : O_SK) + ((size_t)l * DECB + b) * WBUF * 128 + e;
                *(f32x4*)dst = *(const f32x4*)src;
            }
        } PHASE_END
        PHASE_BEGIN { for (int t = F.bid + F.G * F.wave; t < NB * 8 * 4; t += F.G * NWAVES) spass_task(F, l, t); } PHASE_END
        PHASE_BEGIN { for (int u = F.bid; u < NB * NCH; u += F.G) combine_unit(F, l, u); } PHASE_END
        PHASE_BEGIN {
            const EpiMix e{MIX, WSP(f16, WS_ZR)};
            const SchedMix S{XH, YRA, WIN, WBR, F.G, F.bid};
            pg8::gemm_phase(F.lds, D, D, S, EpiBig<EpiMix>{e}, F.tid);
            for (int task = F.gw; task < (MS / 32) * (D / 64); task += F.NGW) {
                const int r0 = MP + 32 * (task % (MS / 32)), c0 = 64 * (task / (MS / 32));
                small_tile(XH, D, WIN + (size_t)OGR * D, D, D, r0, c0, 0, e, F.lane);
                small_tile(YRA, D, WBR, D, RW, r0, c0, 1, e, F.lane);
                small_tile(XH, D, WIN + (size_t)OGA * D, D, D, r0, c0, 2, e, F.lane);
                small_tile(YRA + 512, D, WBR + 512, D, RW, r0, c0, 3, e, F.lane);
            }
        } PHASE_END
        PHASE_BEGIN {
            const EpiRes e{XH};
            const SchedPlain S{MIX, WOUT, D, D, 4, 16, F.G, F.bid};
            pg8::gemm_phase(F.lds, D, D, S, EpiBig<EpiRes>{e}, F.tid);
            sample_gemm(F, F.gw, MIX, D, WOUT, D, D, D / 64, e);
        } PHASE_END
        PHASE_BEGIN ln_rows(F, F.in[22] + (size_t)l * D, F.in[23] + (size_t)l * D, false); PHASE_END
        PHASE_BEGIN {
            const EpiUp e{HB};
            const SchedPlain S{XH, WUP, D, D, 16, 16, F.G, F.bid};
            pg8::gemm_phase(F.lds, D, D, S, EpiBig<EpiUp>{e}, F.tid);
            sample_gemm(F, F.gw, XH, D, WUP, D, D, FF / 64, e);
        } PHASE_END
        PHASE_BEGIN {
            const EpiRes e{XH};
            const SchedPlain S{HB, WDN, FF, FF, 4, 64, F.G, F.bid};
            pg8::gemm_phase(F.lds, FF, FF, S, EpiBig<EpiRes>{e}, F.tid);
            sample_gemm(F, F.gw, HB, FF, WDN, FF, FF, D / 64, e);
        } PHASE_END
        PHASE_BEGIN {
            ln_rows(F, F.in[26] + (size_t)l * D, F.in[27] + (size_t)l * D, l == DEPTH - 1);
            if (l + 1 < DEPTH) { __syncthreads(); convert_layer_weights(F, l + 1); }
        } PHASE_END
    }
}

extern "C" void kernel_launch(void* const* d_in, const int* in_sizes, int n_in, void* d_out, int out_size, void* d_ws, size_t ws_size, hipStream_t stream) {
    static int grid = 0;
    if (grid == 0) {
        if (n_in != 28 || (size_t)out_size != O_END || ws_size < WS_END) fprintf(stderr, "kernel_launch: unexpected shapes: n_in %d out %d (want %zu) ws %zu (want >= %zu)\n", n_in, out_size, (size_t)O_END, ws_size, (size_t)WS_END);
        if (n_in != 28 || ws_size < WS_END) { grid = -1; return; }
        int dev = 0, cus = 0, per_cu = 0;
        if (hipGetDevice(&dev) != hipSuccess || hipDeviceGetAttribute(&cus, hipDeviceAttributeMultiprocessorCount, dev) != hipSuccess) { grid = -1; return; }
        if (hipFuncSetAttribute((const void*)mk_fwd, hipFuncAttributeMaxDynamicSharedMemorySize, LDS_BYTES) != hipSuccess) { fprintf(stderr, "kernel_launch: hipFuncSetAttribute failed\n"); grid = -1; return; }
        if (hipOccupancyMaxActiveBlocksPerMultiprocessor(&per_cu, (const void*)mk_fwd, NTHR, LDS_BYTES) != hipSuccess || per_cu < 1) fprintf(stderr, "kernel_launch: occupancy query says %d\n", per_cu);
        (void)hipGetLastError();
        grid = cus;
    }
    if (grid < 0) return;
    if (hipMemsetAsync((char*)d_ws + WS_CTL, 0, CTL_ZERO_BYTES, stream) != hipSuccess) return;
    KArgs ka{};
    for (int i = 0; i < 28; ++i) ka.a.in[i] = (const float*)d_in[i];
    ka.a.out = (float*)d_out; ka.a.ws = (unsigned char*)d_ws;
    for (int d = 0; d < 32; ++d) ka.invf[d] = pow(10000.0, -(double)d / 32.0);
#if MK_PER_PHASE
    for (int p = 0; p < NPHASE; ++p) { ka.a.ph_lo = p; ka.a.ph_hi = p + 1; ka.a.li = 0; hipLaunchKernelGGL(mk_fwd, dim3(grid), dim3(NTHR), LDS_BYTES, stream, ka); }
#else
    ka.a.ph_lo = 0; ka.a.ph_hi = NPHASE; ka.a.li = 0;
    hipLaunchKernelGGL(mk_fwd, dim3(grid), dim3(NTHR), LDS_BYTES, stream, ka);
#endif
}
```

```cpp
#include <hip/hip_runtime.h>
#include <cstdio>
#include <cstdint>

#define LAS __attribute__((address_space(3)))
#define GAS __attribute__((address_space(1)))
typedef _Float16 f16;
typedef _Float16 f16x2 __attribute__((ext_vector_type(2)));
typedef _Float16 f16x4 __attribute__((ext_vector_type(4)));
typedef _Float16 f16x8 __attribute__((ext_vector_type(8)));
typedef float f32x2 __attribute__((ext_vector_type(2)));
typedef float f32x4 __attribute__((ext_vector_type(4)));
typedef float f32x2 __attribute__((ext_vector_type(2)));
typedef float f32x16 __attribute__((ext_vector_type(16)));
typedef unsigned u32x2 __attribute__((ext_vector_type(2)));
typedef unsigned u32x4 __attribute__((ext_vector_type(4)));

constexpr int D = 1024, SEQ = 8192, NB = 2, DEPTH = 2, DECB = 128, DECT = 4, PAST = 8192;
constexpr int MP = NB * SEQ, MS = DECB * DECT, M = MP + MS;
constexpr int RW = 512, SHW = 1792, INW = 4608, FF = 4096, WBUF = 128;
constexpr int OQ = 1792, OK_ = 2304, OV = 2432, OGR = 2560, OGA = 3584;
constexpr float ALPHA = 1.4142135623730951f;
constexpr float LN_EPS = 1e-5f, GN_EPS = 64e-5f;
constexpr int NWAVES = 8, NTHR = 512;
constexpr int CH = 64;
constexpr int NCH = SEQ / CH;

constexpr size_t MiB = 1u << 20;
constexpr size_t WS_CTL = 0, CTL_ZERO_BYTES = 1 * MiB;
constexpr size_t WS_ROPE = 1 * MiB;
constexpr size_t WS_LORA = 4 * MiB;
constexpr size_t LORA_STRIDE = 256 * 1024;
constexpr size_t WS_WIN = 5 * MiB, WS_WBR = 14 * MiB, WS_WOUT = 16 * MiB, WS_WUP = 18 * MiB, WS_WDN = 26 * MiB;
constexpr size_t WS_XH = 34 * MiB;
constexpr size_t WS_ZR = 67 * MiB;
constexpr size_t WS_YRA = 125 * MiB;
constexpr size_t WS_KB = 158 * MiB, WS_VB = 163 * MiB;
constexpr size_t WS_GG = 168 * MiB;
constexpr size_t WS_MIX = 185 * MiB;
constexpr size_t WS_YSC = 218 * MiB;
constexpr size_t WS_H = 67 * MiB;
constexpr size_t WS_GRS = 250 * MiB, WS_GAS = 251 * MiB;
constexpr size_t WS_GGS = 252 * MiB;
constexpr size_t WS_SLAB = WS_YSC;
constexpr size_t WS_END = 256 * MiB;
static_assert(WS_YSC + 32 * MiB <= WS_END && WS_H + (size_t)M * FF * 2 <= WS_YSC + 32 * MiB, "ws map");

constexpr size_t O_YP = 0, O_YS = O_YP + (size_t)MP * D, O_PWKV = O_YS + (size_t)MS * D, O_PSH = O_PWKV + (size_t)DEPTH * NB * 8 * 64 * 64,
    O_PK = O_PSH + (size_t)DEPTH * NB * SHW, O_PV = O_PK + (size_t)DEPTH * NB * WBUF * 128, O_SWKV = O_PV + (size_t)DEPTH * NB * WBUF * 128,
    O_SSH = O_SWKV + (size_t)DEPTH * DECB * 8 * 64 * 64, O_SK = O_SSH + (size_t)DEPTH * DECB * SHW, O_SV = O_SK + (size_t)DEPTH * DECB * WBUF * 128,
    O_END = O_SV + (size_t)DEPTH * DECB * WBUF * 128;

constexpr int CW_BAR = 4096;

constexpr int LDS_BYTES = 159744;
constexpr int MISC_OFF = 159232;

#define RLX_AGENT __ATOMIC_RELAXED, __HIP_MEMORY_SCOPE_AGENT
#define LDS_WAIT() asm volatile("s_waitcnt lgkmcnt(0)" ::: "memory")
#define VM_WAIT() asm volatile("s_waitcnt vmcnt(0)" ::: "memory")
__device__ __forceinline__ f16x4 cvt4(f32x4 v) { f16x4 r; r.x = (f16)v.x; r.y = (f16)v.y; r.z = (f16)v.z; r.w = (f16)v.w; return r; }
__device__ __forceinline__ f16x8 cvt8(f32x4 a, f32x4 b) { f16x8 r; r[0] = (f16)a.x; r[1] = (f16)a.y; r[2] = (f16)a.z; r[3] = (f16)a.w; r[4] = (f16)b.x; r[5] = (f16)b.y; r[6] = (f16)b.z; r[7] = (f16)b.w; return r; }
__device__ __forceinline__ f32x4 up8lo(f16x8 v) { return (f32x4){(float)v[0], (float)v[1], (float)v[2], (float)v[3]}; }
__device__ __forceinline__ f32x4 up8hi(f16x8 v) { return (f32x4){(float)v[4], (float)v[5], (float)v[6], (float)v[7]}; }
__device__ __forceinline__ f32x4 up4(f16x4 v) { f32x4 r; r.x = (float)v.x; r.y = (float)v.y; r.z = (float)v.z; r.w = (float)v.w; return r; }
__device__ __forceinline__ float rcpf_(float x) { return __builtin_amdgcn_rcpf(x); }
__device__ __forceinline__ float rsqf_(float x) { return __builtin_amdgcn_rsqf(x); }
__device__ __forceinline__ float sigmoidf_(float x) { return rcpf_(1.0f + __expf(-x)); }
__device__ __forceinline__ float shfl_xor_l(float v, int mask, int lane) { return __builtin_bit_cast(float, __builtin_amdgcn_ds_bpermute((lane ^ mask) << 2, __builtin_bit_cast(int, v))); }
__device__ __forceinline__ float wave_sum(float v) {
    int x;
    x = __builtin_amdgcn_update_dpp(0, __builtin_bit_cast(int, v), 0x111, 0xf, 0xf, true); v += __builtin_bit_cast(float, x);
    x = __builtin_amdgcn_update_dpp(0, __builtin_bit_cast(int, v), 0x112, 0xf, 0xf, true); v += __builtin_bit_cast(float, x);
    x = __builtin_amdgcn_update_dpp(0, __builtin_bit_cast(int, v), 0x114, 0xf, 0xf, true); v += __builtin_bit_cast(float, x);
    x = __builtin_amdgcn_update_dpp(0, __builtin_bit_cast(int, v), 0x118, 0xf, 0xf, true); v += __builtin_bit_cast(float, x);
    x = __builtin_amdgcn_update_dpp(0, __builtin_bit_cast(int, v), 0x142, 0xa, 0xf, true); v += __builtin_bit_cast(float, x);
    x = __builtin_amdgcn_update_dpp(0, __builtin_bit_cast(int, v), 0x143, 0xc, 0xf, true); v += __builtin_bit_cast(float, x);
    return __builtin_bit_cast(float, __builtin_amdgcn_readlane(__builtin_bit_cast(int, v), 63));
}
__device__ __forceinline__ float wave_max(float v) {
#pragma unroll
    for (int o = 1; o < 64; o <<= 1) v = fmaxf(v, __shfl_xor(v, o));
    return v;
}

#define XB_TMO      128
#define XB_XCNT(j)  (256  + 64 * (j))
#define XB_XSUB(j)  (1280 + 64 * (j))
#define XB_XGEN(j)  (2304 + 64 * (j))
#define XB_TOP      3328
#define XB_TOPGEN   3392
#define XCD_BAR_WORDS 3456
#define XB_SPIN_CAP (1u << 20)
__device__ __forceinline__ unsigned xb_ld(unsigned* p)              { return __hip_atomic_load(p, __ATOMIC_RELAXED, __HIP_MEMORY_SCOPE_AGENT); }
__device__ __forceinline__ unsigned xb_add(unsigned* p, unsigned v) { return __hip_atomic_fetch_add(p, v, __ATOMIC_RELAXED, __HIP_MEMORY_SCOPE_AGENT); }
__device__ __forceinline__ unsigned xb_xcc_id() { return (unsigned)__builtin_amdgcn_s_getreg((3 << 11) | 20) & 0xFu; }
#define XB_SPIN(cond, bar) do { unsigned _sp = 0; while (cond) { __builtin_amdgcn_s_sleep(1); \
    if ((++_sp & 255u) == 0u) { if (xb_ld(&(bar)[XB_TMO])) break; if (_sp > XB_SPIN_CAP) { atomicAdd(&(bar)[XB_TMO], 1u); break; } } } } while (0)
struct XcdBarrier { unsigned* bar; unsigned x; volatile LAS unsigned* st; };
__device__ __forceinline__ XcdBarrier xcd_barrier_post(unsigned* bar, volatile LAS unsigned* st) {
    XcdBarrier b; b.bar = bar; b.x = xb_xcc_id(); b.st = st;
    if (threadIdx.x == 0) (void)xb_add(&bar[XB_XCNT(b.x)], 1u);
    return b;
}
__device__ __forceinline__ void xcd_barrier_complete(unsigned* bar, unsigned x, unsigned& nloc, unsigned& nx) {
    const unsigned G = gridDim.x * gridDim.y * gridDim.z;
    unsigned sum, cnt, mine, sp = 0u;
    for (;;) {
        sum = 0u; cnt = 0u; mine = 0u;
#pragma unroll
        for (unsigned j = 0; j < 16; ++j) { const unsigned c = xb_ld(&bar[XB_XCNT(j)]); sum += c; cnt += (c > 0u) ? 1u : 0u; mine = (j == x) ? c : mine; }
        if (sum == G) break;
        __builtin_amdgcn_s_sleep(1);
        if ((++sp & 255u) == 0u) { if (xb_ld(&bar[XB_TMO])) break; if (sp > XB_SPIN_CAP) { atomicAdd(&bar[XB_TMO], 1u); break; } }
    }
    nloc = mine > 0u ? mine : 1u; nx = cnt > 0u ? cnt : 1u;
}
__device__ __forceinline__ void xcd_barrier(const XcdBarrier& b, bool leader) {
    asm volatile("s_waitcnt vmcnt(0)" ::: "memory");
    __syncthreads();
    if (leader) {
        unsigned* bar = b.bar;
        __builtin_amdgcn_s_waitcnt(0);
        unsigned nloc = b.st[0], nx = b.st[1];
        if (nloc == 0u) { xcd_barrier_complete(bar, b.x, nloc, nx); b.st[0] = nloc; b.st[1] = nx; }
        const unsigned old = xb_add(&bar[XB_XSUB(b.x)], 1u);
        const unsigned gen = old / nloc;
        if (old + 1u == (gen + 1u) * nloc) {
            __builtin_amdgcn_fence(__ATOMIC_RELEASE, "agent");
            asm volatile("s_waitcnt vmcnt(0)" ::: "memory");
            const unsigned og = xb_add(&bar[XB_TOP], 1u);
            const unsigned tg = og / nx;
            if (og + 1u == (tg + 1u) * nx) xb_add(&bar[XB_TOPGEN], 1u);
            else XB_SPIN(xb_ld(&bar[XB_TOPGEN]) == tg, bar);
            __builtin_amdgcn_fence(__ATOMIC_ACQUIRE, "agent");
            xb_add(&bar[XB_XGEN(b.x)], 1u);
            asm volatile("s_waitcnt vmcnt(0)" ::: "memory");
        } else {
            XB_SPIN(xb_ld(&bar[XB_XGEN(b.x)]) == gen, bar);
            __builtin_amdgcn_fence(__ATOMIC_ACQUIRE, "agent");
            asm volatile("s_waitcnt vmcnt(0)" ::: "memory");
        }
    }
    __syncthreads();
}

namespace pg8 {
constexpr int BM = 256, BK = 64, HALF = 128, HTB = HALF * BK * 2, STAGE_BYTES = 8 * HTB;
__host__ __device__ __forceinline__ int lds_byte(int r, int c) { const int st = (r >> 4) * 2 + (c >> 5), rr = r & 15, cc = c & 31, ob = rr * 64 + cc * 2; return st * 1024 + (ob ^ (((ob >> 9) & 1) << 5)); }
__host__ __device__ __forceinline__ void stage_rc(int b, int& R, int& C) { const int st = b / 1024, sb = b % 1024, swz = sb ^ (((sb >> 9) & 1) << 5); R = (st >> 1) * 16 + swz / 64; C = (st & 1) * 32 + (swz % 64) / 2; }
__host__ __device__ __forceinline__ int permrow(int R) { const int wc = R >> 5, n = (R >> 4) & 1, i = R & 15; return 64 * (wc >> 1) + 16 * (wc & 1) + i + 32 * n; }
__host__ __device__ __forceinline__ int row16(int R, int bj) { return 64 * (R >> 5) + 16 * ((R >> 2) & 3) + 8 * bj + 4 * ((R >> 4) & 1) + (R & 3); }
struct Unit { const char* A; const char* B; int nt, pm, pn, kind, bperm; };

template <class Epi, class Sched>
__device__ __forceinline__ void gemm_phase(LAS unsigned char* lds, const int lda, const int ldb, const Sched& S, const Epi& E, const int tid) {
    const int wid = __builtin_amdgcn_readfirstlane(tid >> 6), lane = tid & 63, wr = wid >> 2, wc = wid & 3, fr = lane & 15, fq = lane >> 4;
    unsigned voffA[2];
#pragma unroll
    for (int i = 0; i < 2; ++i) { int R, C; stage_rc(tid * 16 + i * 8192, R, C); voffA[i] = (unsigned)(R * lda + C) * 2u; }
    unsigned vBc0[2], vBc1[2];
#define PG8_VB(u, v0, v1) do { _Pragma("unroll") for (int _i = 0; _i < 2; ++_i) { int R_, C_; stage_rc(tid * 16 + _i * 8192, R_, C_); \
        const int r0_ = (u).bperm ? row16(R_, 0) : permrow(R_), r1_ = (u).bperm ? row16(R_, 1) : 128 + permrow(R_); \
        v0[_i] = (unsigned)(r0_ * ldb + C_) * 2u; v1[_i] = (unsigned)(r1_ * ldb + C_) * 2u; } } while (0)
    const size_t kstep = (size_t)(BK * 2);
    const size_t hstepA = (size_t)HALF * lda * 2;
    const unsigned ldsw = (unsigned)wid * 1024u;
    const int aoff = lds_byte(wr * 64 + fr, fq * 8), boff = lds_byte(wc * 32 + fr, fq * 8);
#define PG8_SA(b, h) (((b) * 2 + (h)) * HTB)
#define PG8_SB(b, h) ((4 + (b) * 2 + (h)) * HTB)
#define PG8_STAGE(bufoff, gbase, voff) do { _Pragma("unroll") for (int _i = 0; _i < 2; ++_i) \
        __builtin_amdgcn_global_load_lds((const unsigned*)((const char*)(gbase) + (voff)[_i]), (LAS unsigned*)(lds + (bufoff) + ldsw + _i * 8192), 16, 0, 0); } while (0)
#define PG8_LDA(dst, b, h) do { _Pragma("unroll") for (int m = 0; m < 4; ++m) _Pragma("unroll") for (int k = 0; k < 2; ++k) dst[m][k] = *(const LAS f16x8*)(lds + PG8_SA(b, h) + aoff + m * 2048 + k * 1024); } while (0)
#define PG8_LDB(dst, b, h) do { _Pragma("unroll") for (int n = 0; n < 2; ++n) _Pragma("unroll") for (int k = 0; k < 2; ++k) dst[n][k] = *(const LAS f16x8*)(lds + PG8_SB(b, h) + boff + n * 2048 + k * 1024); } while (0)
#define PG8_MMA(ai, bj, At, Bt) do { __builtin_amdgcn_s_setprio(1); _Pragma("unroll") for (int m = 0; m < 4; ++m) _Pragma("unroll") for (int n = 0; n < 2; ++n) _Pragma("unroll") for (int k = 0; k < 2; ++k) \
        acc[ai][bj][m][n] = __builtin_amdgcn_mfma_f32_16x16x32_f16(Bt[n][k], At[m][k], acc[ai][bj][m][n], 0, 0, 0); __builtin_amdgcn_s_setprio(0); } while (0)
#define PG8_WAIT_V(n) asm volatile("s_waitcnt vmcnt(" #n ")" ::: "memory")
#define PG8_WAIT_L(n) asm volatile("s_waitcnt lgkmcnt(" #n ")" ::: "memory")
#define PG8_BAR __builtin_amdgcn_s_barrier()
#define PG8_SCHED __builtin_amdgcn_sched_barrier(0)
    Unit cur, nxt; int ui = 0;
    if (!S.next(0, cur)) return;
    f32x4 acc[2][2][4][2];
#pragma unroll
    for (int a = 0; a < 2; ++a)
#pragma unroll
        for (int b = 0; b < 2; ++b)
#pragma unroll
            for (int m = 0; m < 4; ++m)
#pragma unroll
                for (int n = 0; n < 2; ++n) acc[a][b][m][n] = (f32x4){0.f, 0.f, 0.f, 0.f};
    f16x8 At[4][2], B0[2][2], B1[2][2];
    const char* cA = cur.A; const char* cB = cur.B;
    PG8_VB(cur, vBc0, vBc1);
    PG8_STAGE(PG8_SB(0, 0), cB, vBc0); PG8_STAGE(PG8_SB(0, 1), cB, vBc1); PG8_STAGE(PG8_SA(0, 0), cA, voffA); PG8_STAGE(PG8_SA(0, 1), cA + hstepA, voffA);
    if (wr == 1) PG8_BAR;
    PG8_WAIT_V(2); PG8_BAR;
    PG8_STAGE(PG8_SB(1, 0), cB + kstep, vBc0); PG8_STAGE(PG8_SA(1, 0), cA + kstep, voffA); PG8_STAGE(PG8_SB(1, 1), cB + kstep, vBc1);
    PG8_WAIT_V(6); PG8_BAR;
    for (;;) {
        const bool has_next = S.next(ui + 1, nxt);
        const char* nA = has_next ? nxt.A : cA; const char* nB = has_next ? nxt.B : cB;
        const int nt = cur.nt;
        for (int t = 0; t < nt; t += 2) {
            const bool last = (t == nt - 2);
            unsigned vb0[2], vb1[2]; vb0[0] = vBc0[0]; vb0[1] = vBc0[1]; vb1[0] = vBc1[0]; vb1[1] = vBc1[1];
            if (last && has_next) PG8_VB(nxt, vb0, vb1);
            const char* a1 = cA + (size_t)(t + 1) * kstep;
            const char* a2 = last ? nA : cA + (size_t)(t + 2) * kstep; const char* b2 = last ? nB : cB + (size_t)(t + 2) * kstep;
            const char* a3 = a2 + kstep; const char* b3 = b2 + kstep;
            PG8_LDB(B0, 0, 0); PG8_LDB(B1, 0, 1); PG8_SCHED; PG8_LDA(At, 0, 0); PG8_STAGE(PG8_SA(1, 1), a1 + hstepA, voffA);
            PG8_WAIT_V(8); PG8_WAIT_L(0); PG8_BAR; PG8_MMA(0, 0, At, B0); PG8_MMA(0, 1, At, B1); PG8_BAR; PG8_SCHED;
            PG8_LDA(At, 0, 1); PG8_STAGE(PG8_SB(0, 0), b2, vb0); PG8_STAGE(PG8_SB(0, 1), b2, vb1); PG8_STAGE(PG8_SA(0, 0), a2, voffA);
            PG8_WAIT_V(8); PG8_WAIT_L(0); PG8_BAR; PG8_MMA(1, 0, At, B0); PG8_MMA(1, 1, At, B1); PG8_BAR; PG8_SCHED;
            PG8_LDB(B0, 1, 0); PG8_LDB(B1, 1, 1); PG8_SCHED; PG8_LDA(At, 1, 0); PG8_STAGE(PG8_SA(0, 1), a2 + hstepA, voffA);
            PG8_WAIT_V(8); PG8_WAIT_L(0); PG8_BAR; PG8_MMA(0, 0, At, B0); PG8_MMA(0, 1, At, B1); PG8_BAR; PG8_SCHED;
            PG8_LDA(At, 1, 1); PG8_STAGE(PG8_SB(1, 0), b3, vb0); PG8_STAGE(PG8_SB(1, 1), b3, vb1); PG8_STAGE(PG8_SA(1, 0), a3, voffA);
            PG8_WAIT_V(8); PG8_WAIT_L(0); PG8_BAR; PG8_MMA(1, 0, At, B0); PG8_MMA(1, 1, At, B1); PG8_BAR; PG8_SCHED;
        }
        if (wr == 0) PG8_BAR;
        E(acc, cur, wr, wc, fr, fq);
        if (!has_next) break;
#pragma unroll
        for (int a = 0; a < 2; ++a)
#pragma unroll
            for (int b = 0; b < 2; ++b)
#pragma unroll
                for (int m = 0; m < 4; ++m)
#pragma unroll
                    for (int n = 0; n < 2; ++n) acc[a][b][m][n] = (f32x4){0.f, 0.f, 0.f, 0.f};
        cur = nxt; cA = nA; cB = nB; ++ui; PG8_VB(cur, vBc0, vBc1);
        if (wr == 1) PG8_BAR;
    }
    PG8_WAIT_V(0);
    PG8_BAR;
#undef PG8_SA
#undef PG8_SB
#undef PG8_STAGE
#undef PG8_LDA
#undef PG8_LDB
#undef PG8_MMA
#undef PG8_WAIT_V
#undef PG8_WAIT_L
#undef PG8_BAR
#undef PG8_SCHED
#undef PG8_VB
}
template <class F>
__device__ __forceinline__ void epi_iter(const f32x4 (&acc)[2][2][4][2], const Unit& u, int wr, int wc, int fr, int fq, const F& f) {
#pragma unroll
    for (int ai = 0; ai < 2; ++ai)
#pragma unroll
        for (int m = 0; m < 4; ++m) {
            const int row = u.pm * BM + ai * HALF + wr * 64 + m * 16 + fr;
#pragma unroll
            for (int bj = 0; bj < 2; ++bj) {
                const int col = u.pn * BM + bj * HALF + (wc >> 1) * 64 + (wc & 1) * 16 + 4 * fq;
                f(row, col, acc[ai][bj][m][0], acc[ai][bj][m][1], u.kind);
            }
        }
}
template <class F>
__device__ __forceinline__ void epi_iter16(const f32x4 (&acc)[2][2][4][2], const Unit& u, int wr, int wc, int fr, int fq, const F& f) {
#pragma unroll
    for (int ai = 0; ai < 2; ++ai)
#pragma unroll
        for (int m = 0; m < 4; ++m) {
            const int row = u.pm * BM + ai * HALF + wr * 64 + m * 16 + fr, col = u.pn * BM + 64 * wc + 16 * fq;
            f.op16(row, col, acc[ai][0][m][0], acc[ai][0][m][1], acc[ai][1][m][0], acc[ai][1][m][1], u.kind);
        }
}
}

struct Args { const float* in[28]; float* out; unsigned char* ws; int ph_lo, ph_hi, li, pad; };
struct Frame {
    LAS unsigned char* lds;
    int tid, lane, wave, G, bid, gw, NGW;
    const float* const* in; float* out; unsigned char* ws;
    unsigned long long pacc2;
};
#define WSP(T, off) ((T*)(F.ws + (off)))
__device__ __forceinline__ int fresh_lane() {
    int l; asm volatile("v_mbcnt_lo_u32_b32 %0, -1, 0\n\tv_mbcnt_hi_u32_b32 %0, -1, %0" : "=v"(l));
    __builtin_assume(l >= 0 && l < 64);
    return l;
}
__device__ __forceinline__ void fresh_tid(Frame& F) { const int l = fresh_lane(); F.lane = l; F.tid = F.wave * 64 + l; }

template <class Fn>
__device__ __forceinline__ void small_tile(const f16* __restrict__ A, int lda, const f16* __restrict__ Bt, int ldb, int K, int row0, int col0, int kind, const Fn& f, int lane) {
    f32x16 acc0, acc1;
#pragma unroll
    for (int i = 0; i < 16; ++i) { acc0[i] = 0.f; acc1[i] = 0.f; }
    const f16* ap = A + (size_t)(row0 + (lane & 31)) * lda + 8 * (lane >> 5);
    const f16* b0 = Bt + (size_t)(col0 + (lane & 31)) * ldb + 8 * (lane >> 5);
    const f16* b1 = b0 + (size_t)32 * ldb;
#pragma unroll 4
    for (int k = 0; k < K; k += 16) {
        const f16x8 a = *(const f16x8*)(ap + k), x0 = *(const f16x8*)(b0 + k), x1 = *(const f16x8*)(b1 + k);
        acc0 = __builtin_amdgcn_mfma_f32_32x32x16_f16(x0, a, acc0, 0, 0, 0);
        acc1 = __builtin_amdgcn_mfma_f32_32x32x16_f16(x1, a, acc1, 0, 0, 0);
    }
    const int row = row0 + (lane & 31), cb = col0 + 4 * (lane >> 5);
#pragma unroll
    for (int g = 0; g < 4; ++g)
        f(row, cb + 8 * g, (f32x4){acc0[4 * g], acc0[4 * g + 1], acc0[4 * g + 2], acc0[4 * g + 3]}, (f32x4){acc1[4 * g], acc1[4 * g + 1], acc1[4 * g + 2], acc1[4 * g + 3]}, kind);
}

__device__ __forceinline__ f32x4 sig4(f32x4 v);
struct EpiG1 {
    f16* ZR; f16* YRA; f16* KB; f16* VB; const f32x2* rope; float* out; int l; f16* gateR; f16* gateA;
    __device__ __forceinline__ void operator()(int row, int col, f32x4 v0, f32x4 v1, int) const {
        if (col < OQ) {
            f16* p = ZR + (size_t)row * SHW + col;
            *(f16x4*)p = cvt4(v0); *(f16x4*)(p + 32) = cvt4(v1);
            const bool lastp = row < MP ? ((row & (SEQ - 1)) == SEQ - 1) : (((row - MP) & 3) == 3);
            if (lastp) {
                float* o = row < MP ? out + O_PSH + ((size_t)l * NB + (row >> 13)) * SHW + col : out + O_SSH + ((size_t)l * DECB + ((row - MP) >> 2)) * SHW + col;
                *(f32x4*)o = v0; *(f32x4*)(o + 32) = v1;
            }
        } else if (col < OV) {
            const int pos = row < MP ? (row & (SEQ - 1)) : PAST + ((row - MP) & 3);
            const int d = (col - OQ) & 63;
            const f32x4* rp = (const f32x4*)(rope + (size_t)pos * 32 + d);
            const f32x4 c01 = rp[0], c23 = rp[1];
            const f32x4 c = (f32x4){c01.x, c01.z, c23.x, c23.z}, s = (f32x4){c01.y, c01.w, c23.y, c23.w};
            f32x4 o1 = v0 * c - v1 * s, o2 = v1 * c + v0 * s;
            if (col < OK_) {
                f16* p = YRA + (size_t)row * 1024 + 512 + (col - OQ);
                *(f16x4*)p = cvt4(o1 * 0.125f); *(f16x4*)(p + 32) = cvt4(o2 * 0.125f);
            } else {
                const int kc = col - OK_;
                f16* p = KB + (size_t)row * 128 + kc;
                *(f16x4*)p = cvt4(o1); *(f16x4*)(p + 32) = cvt4(o2);
                if (row < MP) { const int t = row & (SEQ - 1); if (t >= SEQ - WBUF) { float* o = out + O_PK + (((size_t)l * NB + (row >> 13)) * WBUF + (t - (SEQ - WBUF))) * 128 + kc; *(f32x4*)o = o1; *(f32x4*)(o + 32) = o2; } }
                else { float* o = out + O_SK + (((size_t)l * DECB + ((row - MP) >> 2)) * WBUF + (WBUF - DECT + ((row - MP) & 3))) * 128 + kc; *(f32x4*)o = o1; *(f32x4*)(o + 32) = o2; }
            }
        } else if (col >= OGR) {
            f16* p = (col < OGA ? gateR + (col - OGR) : gateA + (col - OGA)) + (size_t)(row - MP) * D;
            *(f16x4*)p = cvt4(sig4(v0)); *(f16x4*)(p + 32) = cvt4(sig4(v1));
        } else {
            const int vc = col - OV;
            f16* p = VB + (size_t)row * 128 + vc;
            *(f16x4*)p = cvt4(v0); *(f16x4*)(p + 32) = cvt4(v1);
            if (row < MP) { const int t = row & (SEQ - 1); if (t >= SEQ - WBUF) { float* o = out + O_PV + (((size_t)l * NB + (row >> 13)) * WBUF + (t - (SEQ - WBUF))) * 128 + vc; *(f32x4*)o = v0; *(f32x4*)(o + 32) = v1; } }
            else { float* o = out + O_SV + (((size_t)l * DECB + ((row - MP) >> 2)) * WBUF + (WBUF - DECT + ((row - MP) & 3))) * 128 + vc; *(f32x4*)o = v0; *(f32x4*)(o + 32) = v1; }
        }
    }
    __device__ __forceinline__ void op16(int row, int col, f32x4 v0, f32x4 v1, f32x4 v2, f32x4 v3, int) const {
        if (col < OQ) {
            f16* p = ZR + (size_t)row * SHW + col;
            *(f16x8*)p = cvt8(v0, v1); *(f16x8*)(p + 8) = cvt8(v2, v3);
            const bool lastp = row < MP ? ((row & (SEQ - 1)) == SEQ - 1) : (((row - MP) & 3) == 3);
            if (lastp) {
                float* o = row < MP ? out + O_PSH + ((size_t)l * NB + (row >> 13)) * SHW + col : out + O_SSH + ((size_t)l * DECB + ((row - MP) >> 2)) * SHW + col;
                *(f32x4*)o = v0; *(f32x4*)(o + 4) = v1; *(f32x4*)(o + 8) = v2; *(f32x4*)(o + 12) = v3;
            }
        } else {
            f16* p = (col < OGA ? gateR + (col - OGR) : gateA + (col - OGA)) + (size_t)(row - MP) * D;
            *(f16x8*)p = cvt8(sig4(v0), sig4(v1)); *(f16x8*)(p + 8) = cvt8(sig4(v2), sig4(v3));
        }
    }
};
__device__ __forceinline__ f32x4 sig4(f32x4 v) { return (f32x4){sigmoidf_(v.x), sigmoidf_(v.y), sigmoidf_(v.z), sigmoidf_(v.w)}; }
constexpr int GHP = 23;
struct EpiMix {
    f16* MIX; f16* TMP; const f16* gateR; const f16* gateA; const f16* GH;
    __device__ __forceinline__ void operator()(int row, int col, f32x4 v0, f32x4 v1, int kind) const {
        f16* p = MIX + (size_t)row * D + col; f16* q = TMP + (size_t)row * D + col;
        if (kind >= 4) {
            const f16* gp = (kind == 4 ? gateR : gateA) + (size_t)(row - MP) * D + col;
            const f32x4 g0 = up4(*(const f16x4*)gp), g1 = up4(*(const f16x4*)(gp + 32));
            f32x4 m0 = (f32x4){0.f, 0.f, 0.f, 0.f}, m1 = m0;
            if (kind == 5) { m0 = up4(*(f16x4*)p); m1 = up4(*(f16x4*)(p + 32)); }
            *(f16x4*)p = cvt4(m0 + g0 * v0); *(f16x4*)(p + 32) = cvt4(m1 + g1 * v1);
            return;
        }
        if (kind == 0) { *(f16x4*)p = cvt4(sig4(v0)); *(f16x4*)(p + 32) = cvt4(sig4(v1)); }
        else if (kind == 1) { const f32x4 m0 = up4(*(f16x4*)p), m1 = up4(*(f16x4*)(p + 32)); *(f16x4*)p = cvt4(m0 * v0); *(f16x4*)(p + 32) = cvt4(m1 * v1); }
        else if (kind == 2) { *(f16x4*)q = cvt4(sig4(v0)); *(f16x4*)(q + 32) = cvt4(sig4(v1)); }
        else { const f32x4 m0 = up4(*(f16x4*)p), m1 = up4(*(f16x4*)(p + 32)), t0 = up4(*(f16x4*)q), t1 = up4(*(f16x4*)(q + 32));
               *(f16x4*)p = cvt4(m0 + t0 * v0); *(f16x4*)(p + 32) = cvt4(m1 + t1 * v1); }
    }
    __device__ __forceinline__ void op16(int row, int col, f32x4 v0, f32x4 v1, f32x4 v2, f32x4 v3, int kind) const {
        f16* p = MIX + (size_t)row * D + col; f16* q = TMP + (size_t)row * D + col;
        if (kind >= 4) {
            const f16* gp = (kind == 4 ? gateR : gateA) + (size_t)(row - MP) * D + col;
            const f16x8 ga = *(const f16x8*)gp, gb = *(const f16x8*)(gp + 8);
            f32x4 m0 = (f32x4){0.f, 0.f, 0.f, 0.f}, m1 = m0, m2 = m0, m3 = m0;
            if (kind == 5) { const f16x8 ma = *(const f16x8*)p, mb = *(const f16x8*)(p + 8); m0 = up8lo(ma); m1 = up8hi(ma); m2 = up8lo(mb); m3 = up8hi(mb); }
            *(f16x8*)p = cvt8(m0 + up8lo(ga) * v0, m1 + up8hi(ga) * v1); *(f16x8*)(p + 8) = cvt8(m2 + up8lo(gb) * v2, m3 + up8hi(gb) * v3);
            return;
        }
        if (kind == 0) { *(f16x8*)p = cvt8(sig4(v0), sig4(v1)); *(f16x8*)(p + 8) = cvt8(sig4(v2), sig4(v3)); }
        else if (kind == 1) { const f16* gp = (row < GHP * 256 ? GH : (const f16*)MIX) + (size_t)row * D + col; const f16x8 ma = *(const f16x8*)gp, mb = *(const f16x8*)(gp + 8);
            *(f16x8*)p = cvt8(up8lo(ma) * v0, up8hi(ma) * v1); *(f16x8*)(p + 8) = cvt8(up8lo(mb) * v2, up8hi(mb) * v3); }
        else if (kind == 2) { *(f16x8*)q = cvt8(sig4(v0), sig4(v1)); *(f16x8*)(q + 8) = cvt8(sig4(v2), sig4(v3)); }
        else { const f16x8 ma = *(const f16x8*)p, mb = *(const f16x8*)(p + 8), ta = *(const f16x8*)q, tb = *(const f16x8*)(q + 8);
            *(f16x8*)p = cvt8(up8lo(ma) + up8lo(ta) * v0, up8hi(ma) + up8hi(ta) * v1); *(f16x8*)(p + 8) = cvt8(up8lo(mb) + up8lo(tb) * v2, up8hi(mb) + up8hi(tb) * v3); }
    }
};
struct EpiRes {
    f16* XH; float* SLAB;
    __device__ __forceinline__ void operator()(int row, int col, f32x4 v0, f32x4 v1, int kind) const {
        if (kind > 0) { f16* sp = (f16*)SLAB + ((size_t)(kind - 1) * MS + (row - MP)) * D + col; *(f16x4*)sp = cvt4(v0); *(f16x4*)(sp + 32) = cvt4(v1); return; }
        f16* p = XH + (size_t)row * D + col;
        const f32x4 x0 = up4(*(f16x4*)p), x1 = up4(*(f16x4*)(p + 32));
        *(f16x4*)p = cvt4(x0 * ALPHA + v0); *(f16x4*)(p + 32) = cvt4(x1 * ALPHA + v1);
    }
    __device__ __forceinline__ void op16(int row, int col, f32x4 v0, f32x4 v1, f32x4 v2, f32x4 v3, int kind) const {
        if (kind > 0) { f16* sp = (f16*)SLAB + ((size_t)(kind - 1) * MS + (row - MP)) * D + col; *(f16x8*)sp = cvt8(v0, v1); *(f16x8*)(sp + 8) = cvt8(v2, v3); return; }
        f16* p = XH + (size_t)row * D + col;
        const f16x8 xa = *(const f16x8*)p, xb = *(const f16x8*)(p + 8);
        *(f16x8*)p = cvt8(up8lo(xa) * ALPHA + v0, up8hi(xa) * ALPHA + v1); *(f16x8*)(p + 8) = cvt8(up8lo(xb) * ALPHA + v2, up8hi(xb) * ALPHA + v3);
    }
};
struct EpiUp {
    f16* H;
    __device__ __forceinline__ void operator()(int row, int col, f32x4 v0, f32x4 v1, int) const {
        f16* p = H + (size_t)row * FF + col;
        f32x4 a = __builtin_elementwise_max(v0, (f32x4){0.f, 0.f, 0.f, 0.f}), b = __builtin_elementwise_max(v1, (f32x4){0.f, 0.f, 0.f, 0.f});
        *(f16x4*)p = cvt4(a * a); *(f16x4*)(p + 32) = cvt4(b * b);
    }
    __device__ __forceinline__ void op16(int row, int col, f32x4 v0, f32x4 v1, f32x4 v2, f32x4 v3, int) const {
        f16* p = H + (size_t)row * FF + col; const f32x4 z = (f32x4){0.f, 0.f, 0.f, 0.f};
        const f32x4 a = __builtin_elementwise_max(v0, z), b = __builtin_elementwise_max(v1, z), c = __builtin_elementwise_max(v2, z), d = __builtin_elementwise_max(v3, z);
        *(f16x8*)p = cvt8(a * a, b * b); *(f16x8*)(p + 8) = cvt8(c * c, d * d);
    }
};
template <class Fn> struct EpiBig16 {
    Fn f;
    __device__ __forceinline__ void operator()(const f32x4 (&acc)[2][2][4][2], const pg8::Unit& u, int wr, int wc, int fr, int fq) const {
        asm volatile("" : "+v"(fr), "+v"(fq));
        pg8::epi_iter16(acc, u, wr, wc, fr, fq, f); }
};
template <class Fn> struct EpiBigR {
    Fn f;
    __device__ __forceinline__ void operator()(const f32x4 (&acc)[2][2][4][2], const pg8::Unit& u, int wr, int wc, int fr, int fq) const {
        asm volatile("" : "+v"(fr), "+v"(fq));
        pg8::epi_iter(acc, u, wr, wc, fr, fq, f); }
};
template <class Fn> struct EpiBig {
    Fn f;
    __device__ __forceinline__ void operator()(const f32x4 (&acc)[2][2][4][2], const pg8::Unit& u, int wr, int wc, int fr, int fq) const {
        asm volatile("" : "+v"(fr), "+v"(fq));
        if (u.bperm) pg8::epi_iter16(acc, u, wr, wc, fr, fq, f); else pg8::epi_iter(acc, u, wr, wc, fr, fq, f); }
};

__device__ __forceinline__ bool tile_of(int L, int nM, int nN, int& pm, int& pn) {
    const int nwg = nM * nN; if (L >= nwg) return false;
    int wgid = L; { const int q = nwg / 8, r = nwg % 8, xcd = wgid % 8, off = wgid / 8; wgid = (xcd < r ? xcd * (q + 1) : r * (q + 1) + (xcd - r) * q) + off; }
    const int WGM = 8, nig = WGM * nN, gid = wgid / nig, fm = gid * WGM, gsz = (nM - fm) < WGM ? (nM - fm) : WGM;
    pm = fm + ((wgid % nig) % gsz); pn = (wgid % nig) / gsz; return true;
}
struct SchedPlain {
    const f16* A; const f16* B; int lda, ldb, nM, nN, nt, G, c;
    __device__ __forceinline__ bool next(int i, pg8::Unit& u) const {
        int pm, pn; if (!tile_of(i * G + c, nM, nN, pm, pn)) return false;
        u.A = (const char*)(A + (size_t)pm * 256 * lda); u.B = (const char*)(B + (size_t)pn * 256 * ldb); u.nt = nt; u.pm = pm; u.pn = pn; u.kind = 0; u.bperm = 1; return true;
    }
};
struct SchedG1 {
    const f16* XH; const f16* WIN; int G, c;
    __device__ __forceinline__ bool next(int i, pg8::Unit& u) const {
        const int L = i * G + c; int pm, pn;
        if (L < 660) tile_of(L, 66, 10, pm, pn);
        else if (L < 676) { pm = 64 + ((L - 660) >> 3); pn = 10 + ((L - 660) & 7); }
        else return false;
        u.A = (const char*)(XH + (size_t)pm * 256 * D); u.B = (const char*)(WIN + (size_t)pn * 256 * D); u.nt = 16; u.pm = pm; u.pn = pn; u.kind = 0; u.bperm = 0; return true;
    }
};
struct SchedG1Z {
    const f16* XH; const f16* WIN; int G, c;
    __device__ __forceinline__ bool next(int i, pg8::Unit& u) const {
        const int L = i * G + c; int pm, pn;
        if (L < 462) tile_of(L, 66, 7, pm, pn);
        else if (L < 478) { pm = 64 + ((L - 462) >> 3); pn = 10 + ((L - 462) & 7); }
        else return false;
        u.A = (const char*)(XH + (size_t)pm * 256 * D); u.B = (const char*)(WIN + (size_t)pn * 256 * D); u.nt = 16; u.pm = pm; u.pn = pn; u.kind = 0; u.bperm = 1; return true;
    }
};
struct SchedG1R {
    const f16* XH; const f16* WIN; int G, c;
    __device__ __forceinline__ bool next(int i, pg8::Unit& u) const {
        int pm, pn; if (!tile_of(i * G + c, 66, 3, pm, pn)) return false; pn += 7;
        u.A = (const char*)(XH + (size_t)pm * 256 * D); u.B = (const char*)(WIN + (size_t)pn * 256 * D); u.nt = 16; u.pm = pm; u.pn = pn; u.kind = 0; u.bperm = 0; return true;
    }
};
struct SchedMix {
    const f16* XH; const f16* YRA; const f16* WIN; const f16* WBR; int G, c, np0, with_sample, pre_gate;
    __device__ __forceinline__ bool next(int i, pg8::Unit& u) const {
        const int np = np0 == 0 ? 0 : (c < 256 ? (256 - c + G - 1) / G : 0), ns = pre_gate ? 3 : 4;
        if (i >= ns * np && !with_sample) return false;
        int pm, pn, k;
        if (i < ns * np) { tile_of((i / ns) * G + c, MP / 256, 4, pm, pn); k = i % ns + (pre_gate ? 1 : 0); }
        else { const int j = i - ns * np, t = c + (j >> 1) * G; if (t >= 8) return false; pm = 64 + (t >> 2); pn = t & 3; k = 4 + (j & 1); }
        u.pm = pm; u.pn = pn; u.kind = k; u.bperm = 1;
        if (k == 0) { u.A = (const char*)(XH + (size_t)pm * 256 * D); u.B = (const char*)(WIN + (size_t)(OGR + pn * 256) * D); u.nt = 16; }
        else if (k == 2) { u.A = (const char*)(XH + (size_t)pm * 256 * D); u.B = (const char*)(WIN + (size_t)(OGA + pn * 256) * D); u.nt = 16; }
        else if (k == 1 || k == 4) { u.A = (const char*)(YRA + (size_t)pm * 256 * D); u.B = (const char*)(WBR + (size_t)pn * 256 * D); u.nt = 8; }
        else { u.A = (const char*)(YRA + (size_t)pm * 256 * D + 512); u.B = (const char*)(WBR + (size_t)pn * 256 * D + 512); u.nt = 8; }
        return true;
    }
};
struct SchedGate {
    const f16* XH; const f16* WIN; int j, p0;
    __device__ __forceinline__ bool next(int i, pg8::Unit& u) const {
        if (i > 0 || j < 0) return false;
        const int pm = p0 + (j >> 2), pn = j & 3;
        u.pm = pm; u.pn = pn; u.kind = 0; u.bperm = 1; u.A = (const char*)(XH + (size_t)pm * 256 * D); u.B = (const char*)(WIN + (size_t)(OGR + pn * 256) * D); u.nt = 16; return true;
    }
};
struct SchedSplit {
    const f16* A; const f16* B; int ld, K, SPL, G, c;
    __device__ __forceinline__ bool next(int i, pg8::Unit& u) const {
        const int np = c < 256 ? (256 - c + G - 1) / G : 0;
        if (i < np) { int pm, pn; tile_of(i * G + c, MP / 256, 4, pm, pn); u.A = (const char*)(A + (size_t)pm * 256 * ld); u.B = (const char*)(B + (size_t)pn * 256 * ld); u.nt = K / 64; u.pm = pm; u.pn = pn; u.kind = 0; u.bperm = 1; return true; }
        const int uu = c + (i - np) * G; if (uu >= 8 * SPL) return false;
        const int t = uu / SPL, s = uu % SPL, ks = K / SPL;
        u.pm = 64 + (t >> 2); u.pn = t & 3; u.kind = 1 + s; u.nt = ks / 64; u.bperm = 1;
        u.A = (const char*)(A + (size_t)u.pm * 256 * ld + (size_t)s * ks); u.B = (const char*)(B + (size_t)u.pn * 256 * ld + (size_t)s * ks); return true;
    }
};

__device__ __forceinline__ void transpose_item(const float* __restrict__ W, int K, int N, f16* __restrict__ dst, int ldd, int koff, LAS float* scr, int item, int lane) {
    const int nblk = N / 32, kb = item / nblk, nb = item % nblk, k0 = 64 * kb, n0 = 32 * nb;
    const int lr = lane >> 3, lc = 4 * (lane & 7);
    f32x4 v[8];
#pragma unroll
    for (int i = 0; i < 8; ++i) v[i] = *(const f32x4*)(W + (size_t)(k0 + 8 * i + lr) * N + n0 + lc);
#pragma unroll
    for (int i = 0; i < 8; ++i) *(LAS f32x4*)(scr + (8 * i + lr) * 36 + lc) = v[i];
    LDS_WAIT(); asm volatile("" ::: "memory");
    const int c = lane & 7;
#pragma unroll
    for (int j = 0; j < 4; ++j) { const int n = (lane >> 3) + 8 * j; const LAS float* s = scr + (8 * c) * 36 + n;
        f16x8 o; o[0] = (f16)s[0 * 36]; o[1] = (f16)s[1 * 36]; o[2] = (f16)s[2 * 36]; o[3] = (f16)s[3 * 36]; o[4] = (f16)s[4 * 36]; o[5] = (f16)s[5 * 36]; o[6] = (f16)s[6 * 36]; o[7] = (f16)s[7 * 36];
        *(f16x8*)(dst + (size_t)(n0 + n) * ldd + koff + k0 + 8 * c) = o; }
    LDS_WAIT(); asm volatile("" ::: "memory");
}
__device__ __forceinline__ void convert_layer_weights(Frame& F, int l, int part, int gw, int ngw) {
    LAS float* scr = (LAS float*)(F.lds + F.wave * 16384);
    constexpr int I_IN = (D / 64) * (INW / 32), I_BR = (RW / 64) * (D / 32), I_OUT = (D / 64) * (D / 32), I_UP = (D / 64) * (FF / 32), I_DN = (FF / 64) * (D / 32);
    constexpr int NIT = I_IN + 2 * I_BR + I_OUT + I_UP + I_DN;
    const int lo = part == 1 ? I_IN : 0, hi = part == 0 ? I_IN : NIT;
    for (int it = lo + gw; it < hi; it += ngw) {
        int r = it;
        if (r < I_IN) { transpose_item(F.in[6] + (size_t)l * D * INW, D, INW, WSP(f16, WS_WIN), D, 0, scr, r, F.lane); continue; } r -= I_IN;
        if (r < I_BR) { transpose_item(F.in[19] + (size_t)l * RW * D, RW, D, WSP(f16, WS_WBR), D, 0, scr, r, F.lane); continue; } r -= I_BR;
        if (r < I_BR) { transpose_item(F.in[20] + (size_t)l * RW * D, RW, D, WSP(f16, WS_WBR), D, 512, scr, r, F.lane); continue; } r -= I_BR;
        if (r < I_OUT) { transpose_item(F.in[21] + (size_t)l * D * D, D, D, WSP(f16, WS_WOUT), D, 0, scr, r, F.lane); continue; } r -= I_OUT;
        if (r < I_UP) { transpose_item(F.in[24] + (size_t)l * D * FF, D, FF, WSP(f16, WS_WUP), D, 0, scr, r, F.lane); continue; } r -= I_UP;
        transpose_item(F.in[25] + (size_t)l * FF * D, FF, D, WSP(f16, WS_WDN), FF, 0, scr, r, F.lane);
    }
}
__device__ __forceinline__ void prologue(Frame& F, const double* invf) {
    convert_layer_weights(F, 0, F.G == 256 ? 0 : 2, F.gw, F.NGW);
    LAS float* scr = (LAS float*)(F.lds + F.wave * 16384);
    constexpr int I_D = (64 / 64) * (RW / 32), I_G = (128 / 64) * (RW / 32), NL = 2 * I_D + I_G;
    for (int it = F.gw; it < DEPTH * NL; it += F.NGW) {
        const int l = it / NL; int r = it % NL; f16* base = (f16*)(F.ws + WS_LORA + (size_t)l * LORA_STRIDE);
        if (r < I_D) { transpose_item(F.in[9] + (size_t)l * 64 * RW, 64, RW, base, 64, 0, scr, r, F.lane); continue; } r -= I_D;
        if (r < I_D) { transpose_item(F.in[11] + (size_t)l * 64 * RW, 64, RW, base + 512 * 64, 64, 0, scr, r, F.lane); continue; } r -= I_D;
        transpose_item(F.in[12] + (size_t)l * 128 * RW, 128, RW, base + 2 * 512 * 64, 128, 0, scr, r, F.lane);
    }
    const size_t gt = (size_t)F.bid * NTHR + F.tid, NT = (size_t)F.G * NTHR;
    for (size_t i = gt; i < (size_t)M * D / 8; i += NT) {
        const size_t e = i * 8; const float* src = e < (size_t)MP * D ? F.in[0] + e : F.in[1] + (e - (size_t)MP * D);
        const f32x4 a = *(const f32x4*)src, b = *(const f32x4*)(src + 4);
        f16x8 o; o[0] = (f16)a.x; o[1] = (f16)a.y; o[2] = (f16)a.z; o[3] = (f16)a.w; o[4] = (f16)b.x; o[5] = (f16)b.y; o[6] = (f16)b.z; o[7] = (f16)b.w;
        *(f16x8*)(WSP(f16, WS_XH) + e) = o;
    }
    f32x2* rope = WSP(f32x2, WS_ROPE);
    for (size_t i = gt; i < (size_t)(PAST + DECT) * 32; i += NT) {
        const int pos = (int)(i >> 5), d = (int)(i & 31);
        const double ang = (double)pos * invf[d];
        const double n = __builtin_rint(ang * 0.63661977236758134308);
        double r = __builtin_fma(-n, 1.57079632679489655800e+00, ang); r = __builtin_fma(-n, 6.12323399573676603587e-17, r);
        const double r2 = r * r;
        double s = -2.50521083854417187751e-08; s = s * r2 + 2.75573192239858906526e-06; s = s * r2 - 1.98412698412698412698e-04; s = s * r2 + 8.33333333333333333333e-03; s = s * r2 - 1.66666666666666666667e-01; s = r + r * r2 * s;
        double c = 2.08767569878680989792e-09; c = c * r2 - 2.75573192239858906526e-07; c = c * r2 + 2.48015873015873015873e-05; c = c * r2 - 1.38888888888888888889e-03; c = c * r2 + 4.16666666666666666667e-02; c = c * r2 - 0.5; c = 1.0 + c * r2;
        const int q = ((int)n) & 3;
        const double cc = (q == 0) ? c : (q == 1) ? -s : (q == 2) ? -c : s;
        const double ss = (q == 0) ? s : (q == 1) ? c : (q == 2) ? -s : -c;
        rope[i] = (f32x2){(float)cc, (float)ss};
    }
}
__device__ __forceinline__ void ln_rows(Frame& F, const float* __restrict__ g, const float* __restrict__ b, bool final_out, int nslab) {
    f16* XH = WSP(f16, WS_XH);
    const f32x4 g0 = *(const f32x4*)(g + F.lane * 8), g1 = *(const f32x4*)(g + F.lane * 8 + 4), g2 = *(const f32x4*)(g + 512 + F.lane * 8), g3 = *(const f32x4*)(g + 512 + F.lane * 8 + 4);
    const f32x4 b0 = *(const f32x4*)(b + F.lane * 8), b1 = *(const f32x4*)(b + F.lane * 8 + 4), b2 = *(const f32x4*)(b + 512 + F.lane * 8), b3 = *(const f32x4*)(b + 512 + F.lane * 8 + 4);
    for (int row = F.gw; row < M; row += F.NGW) {
        f16* p = XH + (size_t)row * D + F.lane * 8;
        const f16x8 h0 = *(const f16x8*)p, h1 = *(const f16x8*)(p + 512);
        f32x4 v0 = (f32x4){(float)h0[0], (float)h0[1], (float)h0[2], (float)h0[3]}, v1 = (f32x4){(float)h0[4], (float)h0[5], (float)h0[6], (float)h0[7]};
        f32x4 v2 = (f32x4){(float)h1[0], (float)h1[1], (float)h1[2], (float)h1[3]}, v3 = (f32x4){(float)h1[4], (float)h1[5], (float)h1[6], (float)h1[7]};
        if (row >= MP) {
            f32x4 a0 = (f32x4){0.f, 0.f, 0.f, 0.f}, a1 = a0, a2 = a0, a3 = a0;
            const f16* sp = WSP(f16, WS_SLAB) + (size_t)(row - MP) * D + F.lane * 8;
            for (int s = 0; s < nslab; ++s, sp += (size_t)MS * D) { const f16x8 p0 = *(const f16x8*)sp, p1 = *(const f16x8*)(sp + 512); a0 += up8lo(p0); a1 += up8hi(p0); a2 += up8lo(p1); a3 += up8hi(p1); }
            v0 = v0 * ALPHA + a0; v1 = v1 * ALPHA + a1; v2 = v2 * ALPHA + a2; v3 = v3 * ALPHA + a3;
        }
        f32x4 sv = (v0 + v1) + (v2 + v3);
        const float mean = wave_sum((sv.x + sv.y) + (sv.z + sv.w)) * (1.f / D);
        v0 -= mean; v1 -= mean; v2 -= mean; v3 -= mean;
        f32x4 qv = (v0 * v0 + v1 * v1) + (v2 * v2 + v3 * v3);
        const float rstd = 1.f / sqrtf(wave_sum((qv.x + qv.y) + (qv.z + qv.w)) * (1.f / D) + LN_EPS);
        v0 = v0 * rstd * g0 + b0; v1 = v1 * rstd * g1 + b1; v2 = v2 * rstd * g2 + b2; v3 = v3 * rstd * g3 + b3;
        if (final_out) {
            float* o = (row < MP ? F.out + O_YP + (size_t)row * D : F.out + O_YS + (size_t)(row - MP) * D) + F.lane * 8;
            *(f32x4*)o = v0; *(f32x4*)(o + 4) = v1; *(f32x4*)(o + 512) = v2; *(f32x4*)(o + 516) = v3;
        } else {
            f16x8 o0, o1;
            o0[0] = (f16)v0.x; o0[1] = (f16)v0.y; o0[2] = (f16)v0.z; o0[3] = (f16)v0.w; o0[4] = (f16)v1.x; o0[5] = (f16)v1.y; o0[6] = (f16)v1.z; o0[7] = (f16)v1.w;
            o1[0] = (f16)v2.x; o1[1] = (f16)v2.y; o1[2] = (f16)v2.z; o1[3] = (f16)v2.w; o1[4] = (f16)v3.x; o1[5] = (f16)v3.y; o1[6] = (f16)v3.z; o1[7] = (f16)v3.w;
            *(f16x8*)p = o0; *(f16x8*)(p + 512) = o1;
        }
    }
}
template <class Fn>
__device__ __forceinline__ void sample_gemm(Frame& F, int gws, const f16* A, int lda, const f16* Bt, int ldb, int K, int ncg, const Fn& f) {
    for (int task = gws; task < (MS / 32) * ncg; task += F.NGW)
        small_tile(A, lda, Bt, ldb, K, MP + 32 * (task % (MS / 32)), 64 * (task / (MS / 32)), 0, f, F.lane);
}

constexpr int AT_KS = 72, AT_VS = 264;
constexpr int AT_KOFF = 0, AT_VOFF = 256 * AT_KS * 2;
__device__ __forceinline__ void attn_prompt_unit(Frame& F, int l, int unit) {
    const int g = unit & 1, qb = (unit >> 1) & 63, b = unit >> 7;
    const int R0 = b * SEQ + 128 * qb;
    f16* YRA = WSP(f16, WS_YRA); const f16* KB = WSP(f16, WS_KB); const f16* VB = WSP(f16, WS_VB);
    LAS f16* Ks = (LAS f16*)(F.lds + AT_KOFF); LAS f16* Vt = (LAS f16*)(F.lds + AT_VOFF);
    __syncthreads();
#pragma unroll
    for (int i = 0; i < 4; ++i) {
        const int idx = F.tid + 512 * i, key = idx >> 3, ch = idx & 7;
        f16x8 kv, vv;
        if (qb == 0 && key < 128) { for (int e = 0; e < 8; ++e) { kv[e] = (f16)0.f; vv[e] = (f16)0.f; } }
        else { const size_t ro = (size_t)(R0 - 128 + key) * 128 + g * 64 + 8 * ch; kv = *(const f16x8*)(KB + ro); vv = *(const f16x8*)(VB + ro); }
        *(LAS f16x8*)(Ks + key * AT_KS + 8 * ch) = kv;
#pragma unroll
        for (int e = 0; e < 8; ++e) Vt[(8 * ch + e) * AT_VS + key] = vv[e];
    }
    __syncthreads();
    const int lane = F.lane, ql = lane & 31, h = lane >> 5;
    for (int s2 = 0; s2 < 2; ++s2) {
        const int task = F.wave * 2 + s2, hh = task >> 2, sb = task & 3, head = 4 * g + hh;
        f16* qrow = YRA + (size_t)(R0 + 32 * sb + ql) * D + 512 + head * 64;
        f16x8 qf[4];
#pragma unroll
        for (int kk = 0; kk < 4; ++kk) qf[kk] = *(const f16x8*)(qrow + 16 * kk + 8 * h);
        const float sink = F.in[18][l * 8 + head];
        f32x16 sc[5];
#pragma unroll
        for (int kt = 0; kt < 5; ++kt) {
#pragma unroll
            for (int i = 0; i < 16; ++i) sc[kt][i] = 0.f;
            const LAS f16* kp = Ks + (32 * (sb + kt) + ql) * AT_KS + 8 * h;
#pragma unroll
            for (int kk = 0; kk < 4; ++kk) sc[kt] = __builtin_amdgcn_mfma_f32_32x32x16_f16(*(const LAS f16x8*)(kp + 16 * kk), qf[kk], sc[kt], 0, 0, 0);
        }
        float mx = sink;
#pragma unroll
        for (int kt = 0; kt < 5; ++kt) {
            const bool tile_ok = (qb > 0) || (sb + kt >= 4);
#pragma unroll
            for (int r = 0; r < 16; ++r) {
                const int kl = (r & 3) + 8 * (r >> 2) + 4 * h;
                bool ok = tile_ok; if (kt == 0) ok = ok && (kl >= ql); if (kt == 4) ok = ok && (kl <= ql);
                sc[kt][r] = ok ? sc[kt][r] : -INFINITY;
                mx = fmaxf(mx, sc[kt][r]);
            }
        }
        mx = fmaxf(mx, shfl_xor_l(mx, 32, lane));
        float sum = 0.f;
#pragma unroll
        for (int kt = 0; kt < 5; ++kt)
#pragma unroll
            for (int r = 0; r < 16; ++r) { const float p = __expf(sc[kt][r] - mx); sc[kt][r] = p; sum += p; }
        sum += shfl_xor_l(sum, 32, lane);
        const float inv = rcpf_(sum + __expf(sink - mx));
        f32x16 o0, o1;
#pragma unroll
        for (int i = 0; i < 16; ++i) { o0[i] = 0.f; o1[i] = 0.f; }
#pragma unroll
        for (int kt = 0; kt < 5; ++kt)
#pragma unroll
            for (int s = 0; s < 2; ++s) {
                f16x8 pf;
#pragma unroll
                for (int j = 0; j < 8; ++j) pf[j] = (f16)(sc[kt][8 * s + j] * inv);
                const int kc = 32 * (sb + kt) + 16 * s + 4 * h;
                const LAS f16* v0p = Vt + ql * AT_VS + kc; const LAS f16* v1p = v0p + 32 * AT_VS;
                const f16x4 a0 = *(const LAS f16x4*)v0p, a1 = *(const LAS f16x4*)(v0p + 8), c0 = *(const LAS f16x4*)v1p, c1 = *(const LAS f16x4*)(v1p + 8);
                const f16x8 vf0 = (f16x8){a0.x, a0.y, a0.z, a0.w, a1.x, a1.y, a1.z, a1.w}, vf1 = (f16x8){c0.x, c0.y, c0.z, c0.w, c1.x, c1.y, c1.z, c1.w};
                o0 = __builtin_amdgcn_mfma_f32_32x32x16_f16(vf0, pf, o0, 0, 0, 0);
                o1 = __builtin_amdgcn_mfma_f32_32x32x16_f16(vf1, pf, o1, 0, 0, 0);
            }
#pragma unroll
        for (int gq = 0; gq < 4; ++gq) {
            *(f16x4*)(qrow + 8 * gq + 4 * h) = cvt4((f32x4){o0[4 * gq], o0[4 * gq + 1], o0[4 * gq + 2], o0[4 * gq + 3]});
            *(f16x4*)(qrow + 32 + 8 * gq + 4 * h) = cvt4((f32x4){o1[4 * gq], o1[4 * gq + 1], o1[4 * gq + 2], o1[4 * gq + 3]});
        }
    }
}
__device__ __forceinline__ void attn_sample_task(Frame& F, int l, int task) {
    const int g = task & 1, b = task >> 1, lane = F.lane, ql = lane & 31, h = lane >> 5;
    f16* YRA = WSP(f16, WS_YRA); const f16* KB = WSP(f16, WS_KB); const f16* VB = WSP(f16, WS_VB);
    const float* ck = F.in[4] + ((size_t)l * DECB + b) * WBUF * 128 + g * 64; const float* cv = F.in[5] + ((size_t)l * DECB + b) * WBUF * 128 + g * 64;
    const int rr = ql & 15, qi = rr >> 2, head = 4 * g + (rr & 3);
    f16* qrow = YRA + (size_t)(MP + 4 * b + qi) * D + 512 + head * 64;
    f16x8 qf[4];
#pragma unroll
    for (int kk = 0; kk < 4; ++kk) qf[kk] = *(const f16x8*)(qrow + 16 * kk + 8 * h);
    const float sink = F.in[18][l * 8 + head];
    f32x16 sc[5];
#pragma unroll
    for (int kt = 0; kt < 5; ++kt) {
#pragma unroll
        for (int i = 0; i < 16; ++i) sc[kt][i] = 0.f;
        const int key = 32 * kt + ql;
#pragma unroll
        for (int kk = 0; kk < 4; ++kk) {
            f16x8 kf;
            if (key < WBUF) { const f32x4 a = *(const f32x4*)(ck + (size_t)key * 128 + 16 * kk + 8 * h), c2 = *(const f32x4*)(ck + (size_t)key * 128 + 16 * kk + 8 * h + 4);
                kf = (f16x8){(f16)a.x, (f16)a.y, (f16)a.z, (f16)a.w, (f16)c2.x, (f16)c2.y, (f16)c2.z, (f16)c2.w}; }
            else if (key < WBUF + DECT) kf = *(const f16x8*)(KB + (size_t)(MP + 4 * b + key - WBUF) * 128 + g * 64 + 16 * kk + 8 * h);
            else kf = (f16x8){(f16)0.f, (f16)0.f, (f16)0.f, (f16)0.f, (f16)0.f, (f16)0.f, (f16)0.f, (f16)0.f};
            sc[kt] = __builtin_amdgcn_mfma_f32_32x32x16_f16(kf, qf[kk], sc[kt], 0, 0, 0);
        }
    }
    float mx = sink;
#pragma unroll
    for (int kt = 0; kt < 5; ++kt)
#pragma unroll
        for (int r = 0; r < 16; ++r) {
            const int key = 32 * kt + (r & 3) + 8 * (r >> 2) + 4 * h;
            const bool ok = key < WBUF ? (key >= qi) : (key < WBUF + DECT && key - WBUF <= qi);
            sc[kt][r] = ok ? sc[kt][r] : -INFINITY; mx = fmaxf(mx, sc[kt][r]);
        }
    mx = fmaxf(mx, shfl_xor_l(mx, 32, lane));
    float sum = 0.f;
#pragma unroll
    for (int kt = 0; kt < 5; ++kt)
#pragma unroll
        for (int r = 0; r < 16; ++r) { const float p = __expf(sc[kt][r] - mx); sc[kt][r] = p; sum += p; }
    sum += shfl_xor_l(sum, 32, lane);
    const float inv = rcpf_(sum + __expf(sink - mx));
    f32x16 o0, o1;
#pragma unroll
    for (int i = 0; i < 16; ++i) { o0[i] = 0.f; o1[i] = 0.f; }
#pragma unroll
    for (int kt = 0; kt < 5; ++kt)
#pragma unroll
        for (int s = 0; s < 2; ++s) {
            f16x8 pf, vf0, vf1;
#pragma unroll
            for (int j = 0; j < 8; ++j) {
                pf[j] = (f16)(sc[kt][8 * s + j] * inv);
                const int key = 32 * kt + 16 * s + 8 * (j >> 2) + 4 * h + (j & 3);
                float x0 = 0.f, x1 = 0.f;
                if (key < WBUF) { x0 = cv[(size_t)key * 128 + ql]; x1 = cv[(size_t)key * 128 + 32 + ql]; }
                else if (key < WBUF + DECT) { const f16* vp = VB + (size_t)(MP + 4 * b + key - WBUF) * 128 + g * 64; x0 = (float)vp[ql]; x1 = (float)vp[32 + ql]; }
                vf0[j] = (f16)x0; vf1[j] = (f16)x1;
            }
            o0 = __builtin_amdgcn_mfma_f32_32x32x16_f16(vf0, pf, o0, 0, 0, 0);
            o1 = __builtin_amdgcn_mfma_f32_32x32x16_f16(vf1, pf, o1, 0, 0, 0);
        }
    if (ql < 16) {
#pragma unroll
        for (int gq = 0; gq < 4; ++gq) {
            *(f16x4*)(qrow + 8 * gq + 4 * h) = cvt4((f32x4){o0[4 * gq], o0[4 * gq + 1], o0[4 * gq + 2], o0[4 * gq + 3]});
            *(f16x4*)(qrow + 32 + 8 * gq + 4 * h) = cvt4((f32x4){o1[4 * gq], o1[4 * gq + 1], o1[4 * gq + 2], o1[4 * gq + 3]});
        }
    }
}

template <int T> struct RL { static constexpr int W = 0, AL = T * 256, BE = 2 * T * 256, RK = 3 * T * 256, V = RK + T * 256, SIZE = V + T * 128; };
constexpr int SH_P = 264, RAW_OFF = 8 * RL<8>::SIZE, RAW_SZ = 32768, SHP_OFF = RAW_OFF + 2 * RAW_SZ, SHS_OFF = 8 * RL<16>::SIZE;
constexpr int PRM_OFF = SHP_OFF + 8 * SH_P * 2, PR_DB = 0, PR_MU = 2048, PR_IB = PR_MU + 3584, PR_KK = PR_IB + 1024, PR_KA = PR_KK + 1024, PR_RK = PR_KA + 1024, PRM_SZ = PR_RK + 1024;
static_assert(PRM_OFF + PRM_SZ <= MISC_OFF && SHS_OFF + 16 * SH_P * 2 <= MISC_OFF, "scan LDS map");
#define CFENCE() asm volatile("" ::: "memory")
struct RwkvP { const f16* ZR; f16* YRA; f16* GG; const f16* lora; const float *mu, *dbase, *ibase, *kk_, *ka_, *rk_, *sshift; };
__device__ __forceinline__ RwkvP rwkv_params(Frame& F, int l) {
    RwkvP P; P.ZR = WSP(f16, WS_ZR); P.YRA = WSP(f16, WS_YRA); P.GG = WSP(f16, WS_GGS); P.lora = (const f16*)(F.ws + WS_LORA + (size_t)l * LORA_STRIDE);
    P.mu = F.in[7] + (size_t)l * SHW; P.dbase = F.in[8] + (size_t)l * RW; P.ibase = F.in[10] + (size_t)l * RW; P.kk_ = F.in[13] + (size_t)l * RW; P.ka_ = F.in[14] + (size_t)l * RW;
    P.rk_ = F.in[15] + (size_t)l * RW; P.sshift = F.in[3] + (size_t)l * DECB * SHW; return P;
}
template <bool SAMPLE>
__device__ __forceinline__ f32x4 par4(const float* g, const LAS unsigned char* prm, int off, int i) {
    if (SAMPLE) return *(const f32x4*)(g + i);
    return up4(*(const LAS f16x4*)(prm + off + 2 * i));
}
template <bool SAMPLE>
__device__ __forceinline__ f32x4 zs4(const RwkvP& P, const LAS f16* raw, const LAS unsigned char* prm, int row, int tl, int col) {
    f32x4 z, pv;
    if (SAMPLE) {
        z = up4(*(const f16x4*)(P.ZR + (size_t)row * SHW + col));
        if (((row - MP) & 3) == 0) pv = *(const f32x4*)(P.sshift + (size_t)((row - MP) >> 2) * SHW + col); else pv = up4(*(const f16x4*)(P.ZR + (size_t)(row - 1) * SHW + col));
    } else {
        z = up4(*(const LAS f16x4*)(raw + (tl + 1) * SHW + col));
        pv = up4(*(const LAS f16x4*)(raw + tl * SHW + col));
        if ((row & (SEQ - 1)) == 0) pv = (f32x4){0.f, 0.f, 0.f, 0.f};
    }
    f32x4 m;
    if (SAMPLE) m = *(const f32x4*)(P.mu + col); else m = up4(*(const LAS f16x4*)(prm + PR_MU + 2 * col));
    return z + (pv - z) * m;
}
__device__ __forceinline__ float lora_act(float x, int col) {
    const float sc = col < 64 ? 2.0f : 1.0f, cc = col < 64 ? -1.0f : 0.0f;
    const float y = sc * rcpf_(1.0f + __expf(-sc * x)) + cc;
    return (col >= 64 && col < 128) ? x : y;
}
template <bool SAMPLE>
__device__ __forceinline__ void rwkv_prepA(const RwkvP& P, int wave, int row0, const LAS f16* raw, const LAS unsigned char* prm, LAS f16* sh, int lane) {
    if (SAMPLE) {
        if (wave >= 2) return;
        const int tk = 2 * wave + (lane >> 5), c8 = 8 * (lane & 31), row = row0 + tk;
        const f32x4 a = zs4<true>(P, raw, prm, row, tk, 3 * RW + c8), b = zs4<true>(P, raw, prm, row, tk, 3 * RW + c8 + 4);
        f16x8 o;
#pragma unroll
        for (int e = 0; e < 8; ++e) o[e] = (f16)lora_act(e < 4 ? a[e & 3] : b[e & 3], c8);
        *(LAS f16x8*)(sh + tk * SH_P + c8) = o;
    } else {
        const int tk = wave, c4 = 4 * lane, row = row0 + tk;
        const f32x4 a = zs4<false>(P, raw, prm, row, tk, 3 * RW + c4);
        f16x4 o;
#pragma unroll
        for (int e = 0; e < 4; ++e) o[e] = (f16)lora_act(a[e], c4);
        *(LAS f16x4*)(sh + tk * SH_P + c4) = o;
    }
}
template <bool SAMPLE, int T>
__device__ __forceinline__ void rwkv_prepB(const RwkvP& P, int h, int row0, const LAS f16* raw, const LAS unsigned char* prm, const LAS f16* shb, LAS unsigned char* wl, int lane) {
    typedef RL<T> L;
    const int tl = (lane & 15) & (T - 1), q = lane >> 4, row = row0 + tl;
    const bool st = SAMPLE || ((lane & 15) < T);
    const f16* DU = P.lora + (size_t)(h * 64 + (lane & 15)) * 64 + 8 * q; const f16* IU = DU + 512 * 64; const f16* GU = P.lora + 2 * 512 * 64 + (size_t)(h * 64 + (lane & 15)) * 128 + 8 * q;
    const LAS f16* sh = shb + tl * SH_P + 8 * q;
    f32x4 acc[4];
#pragma unroll
    for (int nt = 0; nt < 4; ++nt) acc[nt] = (f32x4){0.f, 0.f, 0.f, 0.f};
#pragma unroll
    for (int kk = 0; kk < 2; ++kk) { const f16x8 fr = *(const LAS f16x8*)(sh + 32 * kk);
#pragma unroll
        for (int nt = 0; nt < 4; ++nt) acc[nt] = __builtin_amdgcn_mfma_f32_16x16x32_f16(*(const f16x8*)(DU + (size_t)nt * 16 * 64 + 32 * kk), fr, acc[nt], 0, 0, 0); }
#pragma unroll
    for (int nt = 0; nt < 4; ++nt) {
        const int c4 = 16 * nt + 4 * q;
        const f32x4 sg = sig4((SAMPLE ? *(const f32x4*)(P.dbase + h * 64 + c4) : *(const LAS f32x4*)(prm + PR_DB + 4 * (h * 64 + c4))) + acc[nt]);
        f32x4 w; w.x = __expf(-0.60653065971263342f * sg.x); w.y = __expf(-0.60653065971263342f * sg.y); w.z = __expf(-0.60653065971263342f * sg.z); w.w = __expf(-0.60653065971263342f * sg.w);
        if (st) *(LAS f32x4*)(wl + L::W + (tl * 64 + c4) * 4) = w;
    }
    CFENCE();
    if (SAMPLE) {
#pragma unroll
        for (int nt = 0; nt < 4; ++nt) acc[nt] = (f32x4){0.f, 0.f, 0.f, 0.f};
#pragma unroll
        for (int kk = 0; kk < 4; ++kk) { const f16x8 fr = *(const LAS f16x8*)(sh + 128 + 32 * kk);
#pragma unroll
            for (int nt = 0; nt < 4; ++nt) acc[nt] = __builtin_amdgcn_mfma_f32_16x16x32_f16(*(const f16x8*)(GU + (size_t)nt * 16 * 128 + 32 * kk), fr, acc[nt], 0, 0, 0); }
#pragma unroll
        for (int nt = 0; nt < 4; ++nt) *(f16x4*)(P.GG + (size_t)(row - MP) * RW + h * 64 + 16 * nt + 4 * q) = cvt4(acc[nt]);
        CFENCE();
    }
#pragma unroll
    for (int nt = 0; nt < 4; ++nt) acc[nt] = (f32x4){0.f, 0.f, 0.f, 0.f};
#pragma unroll
    for (int kk = 0; kk < 2; ++kk) { const f16x8 fr = *(const LAS f16x8*)(sh + 64 + 32 * kk);
#pragma unroll
        for (int nt = 0; nt < 4; ++nt) acc[nt] = __builtin_amdgcn_mfma_f32_16x16x32_f16(*(const f16x8*)(IU + (size_t)nt * 16 * 64 + 32 * kk), fr, acc[nt], 0, 0, 0); }
    float ssq = 0.f, bon = 0.f;
#pragma unroll
    for (int nt = 0; nt < 4; ++nt) {
        const int c4 = 16 * nt + 4 * q, ch = h * 64 + c4;
        const f32x4 av = sig4(par4<SAMPLE>(P.ibase, prm, PR_IB, ch) + acc[nt]);
        const f32x4 rv = zs4<SAMPLE>(P, raw, prm, row, tl, ch), kx = zs4<SAMPLE>(P, raw, prm, row, tl, RW + ch), vv = zs4<SAMPLE>(P, raw, prm, row, tl, 2 * RW + ch);
        const f32x4 kkv = kx * par4<SAMPLE>(P.kk_, prm, PR_KK, ch);
        const f32x4 kp = kx * (1.0f + (av - 1.0f) * par4<SAMPLE>(P.ka_, prm, PR_KA, ch));
        const f32x4 s2 = kkv * kkv; ssq += (s2.x + s2.y) + (s2.z + s2.w);
        const f32x4 b2 = rv * kp * par4<SAMPLE>(P.rk_, prm, PR_RK, ch); bon += (b2.x + b2.y) + (b2.z + b2.w);
        if (st) {
            *(LAS f32x4*)(wl + L::AL + (tl * 64 + c4) * 4) = kkv;
            *(LAS f32x4*)(wl + L::BE + (tl * 64 + c4) * 4) = av;
            *(LAS f16x4*)(wl + L::RK + (tl * 64 + c4) * 4) = cvt4(rv);
            *(LAS f16x4*)(wl + L::RK + (tl * 64 + c4) * 4 + 8) = cvt4(kp);
            *(LAS f16x4*)(wl + L::V + (tl * 64 + c4) * 2) = cvt4(vv);
        }
        CFENCE();
    }
    ssq += shfl_xor_l(ssq, 16, lane); ssq += shfl_xor_l(ssq, 32, lane); bon += shfl_xor_l(bon, 16, lane); bon += shfl_xor_l(bon, 32, lane);
    const float inv = rsqf_(fmaxf(ssq, 1e-24f));
    LDS_WAIT();
    if (st) {
#pragma unroll
        for (int nt = 0; nt < 4; ++nt) {
            const int c4 = 16 * nt + 4 * q;
            const f32x4 kn = *(const LAS f32x4*)(wl + L::AL + (tl * 64 + c4) * 4) * inv, av = *(const LAS f32x4*)(wl + L::BE + (tl * 64 + c4) * 4);
            *(LAS f32x4*)(wl + L::AL + (tl * 64 + c4) * 4) = -kn;
            *(LAS f32x4*)(wl + L::BE + (tl * 64 + c4) * 4) = kn * av;
            const f32x4 vv = up4(*(const LAS f16x4*)(wl + L::V + (tl * 64 + c4) * 2));
            *(f16x4*)(P.YRA + (size_t)row * D + h * 64 + c4) = cvt4(vv * bon);
        }
    }
    CFENCE();
}
template <bool HAS_P, int T>
__device__ __forceinline__ void scan_step(float (&SP)[64], float (&SU)[64], const LAS unsigned char* wl, int t, float vv, float& yp, float& yu) {
    typedef RL<T> L;
    const LAS unsigned char* pa = wl + L::AL + t * 256; const LAS unsigned char* pw = wl + L::W + t * 256; const LAS unsigned char* pb = wl + L::BE + t * 256;
    const LAS unsigned char* pk = wl + L::RK + t * 256;
    constexpr int DA = 4, DB = 2;
    f32x4 A[DA], W[DB], B[DB]; f16x8 RK[DB];
#pragma unroll
    for (int i = 0; i < DA; ++i) A[i] = *(const LAS f32x4*)(pa + 16 * i);
    float saP = 0.f, saU = 0.f;
#pragma unroll
    for (int g = 0; g < 16; ++g) {
        const f32x4 a = A[g % DA];
        if (g + DA < 16) A[g % DA] = *(const LAS f32x4*)(pa + 16 * (g + DA));
#pragma unroll
        for (int e = 0; e < 4; ++e) { saU = fmaf(SU[4 * g + e], a[e], saU); if (HAS_P) saP = fmaf(SP[4 * g + e], a[e], saP); }
        if (g == 16 - DB) {
#pragma unroll
            for (int i = 0; i < DB; ++i) { W[i] = *(const LAS f32x4*)(pw + 16 * i); B[i] = *(const LAS f32x4*)(pb + 16 * i); RK[i] = *(const LAS f16x8*)(pk + 16 * i); }
        }
        CFENCE();
    }
    float yP = 0.f, yU = 0.f;
#pragma unroll
    for (int g = 0; g < 16; ++g) {
        const f32x4 w = W[g % DB], be = B[g % DB]; const f16x8 rk = RK[g % DB];
        if (g + DB < 16) { W[g % DB] = *(const LAS f32x4*)(pw + 16 * (g + DB)); B[g % DB] = *(const LAS f32x4*)(pb + 16 * (g + DB)); RK[g % DB] = *(const LAS f16x8*)(pk + 16 * (g + DB)); }
#pragma unroll
        for (int e = 0; e < 4; ++e) {
            const int k = 4 * g + e;
            float u = fmaf(vv, (float)rk[4 + e], be[e] * saU);
            SU[k] = fmaf(SU[k], w[e], u);
            yU = fmaf(SU[k], (float)rk[e], yU);
            if (HAS_P) { SP[k] = fmaf(SP[k], w[e], be[e] * saP); yP = fmaf(SP[k], (float)rk[e], yP); }
        }
        CFENCE();
    }
    yp = yP; yu = yU;
}
__device__ __forceinline__ float quad_sum(float v) {
    v += __builtin_bit_cast(float, __builtin_amdgcn_update_dpp(0, __builtin_bit_cast(int, v), 0xB1, 0xf, 0xf, true));
    v += __builtin_bit_cast(float, __builtin_amdgcn_update_dpp(0, __builtin_bit_cast(int, v), 0x4E, 0xf, 0xf, true));
    return v;
}
__device__ __forceinline__ f32x2 fma2(f32x2 a, f32x2 b, f32x2 c) { return __builtin_elementwise_fma(a, b, c); }
__device__ __forceinline__ void scan_step_q(f32x2 (&SP)[4][8], f32x2 (&SU)[4][8], LAS unsigned char* wl, int t, int Q, int sub) {
    typedef RL<8> L;
    const LAS unsigned char* pa = wl + L::AL + t * 256 + 64 * sub; const LAS unsigned char* pw = wl + L::W + t * 256 + 64 * sub; const LAS unsigned char* pb = wl + L::BE + t * 256 + 64 * sub;
    const LAS unsigned char* pk = wl + L::RK + t * 256 + 64 * sub;
    f32x4 A[4], W[2], B[2]; f16x8 RK[2];
#pragma unroll
    for (int i = 0; i < 4; ++i) A[i] = *(const LAS f32x4*)(pa + 16 * i);
    const f16x4 v4 = *(const LAS f16x4*)(wl + L::V + (t * 64 + 4 * Q) * 2);
    f32x2 dP[4], dU[4];
#pragma unroll
    for (int r = 0; r < 4; ++r) { dP[r] = (f32x2){0.f, 0.f}; dU[r] = (f32x2){0.f, 0.f}; }
#pragma unroll
    for (int g = 0; g < 4; ++g) {
        const f32x2 alo = A[g].xy, ahi = A[g].zw;
#pragma unroll
        for (int r = 0; r < 4; ++r) { dU[r] = fma2(SU[r][2 * g], alo, dU[r]); dP[r] = fma2(SP[r][2 * g], alo, dP[r]); }
#pragma unroll
        for (int r = 0; r < 4; ++r) { dU[r] = fma2(SU[r][2 * g + 1], ahi, dU[r]); dP[r] = fma2(SP[r][2 * g + 1], ahi, dP[r]); }
        if (g == 1) {
#pragma unroll
            for (int i = 0; i < 2; ++i) { W[i] = *(const LAS f32x4*)(pw + 16 * i); B[i] = *(const LAS f32x4*)(pb + 16 * i); RK[i] = *(const LAS f16x8*)(pk + 16 * i); }
        }
        CFENCE();
    }
    float saP[4], saU[4], vv[4];
#pragma unroll
    for (int r = 0; r < 4; ++r) { saU[r] = quad_sum(dU[r].x + dU[r].y); saP[r] = quad_sum(dP[r].x + dP[r].y); vv[r] = (float)v4[r]; }
    f32x2 yP[4], yU[4];
#pragma unroll
    for (int r = 0; r < 4; ++r) { yP[r] = (f32x2){0.f, 0.f}; yU[r] = (f32x2){0.f, 0.f}; }
#pragma unroll
    for (int g = 0; g < 4; ++g) {
        const f32x4 w = W[g & 1], be = B[g & 1]; const f16x8 rk = RK[g & 1];
        if (g + 2 < 4) { W[g & 1] = *(const LAS f32x4*)(pw + 16 * (g + 2)); B[g & 1] = *(const LAS f32x4*)(pb + 16 * (g + 2)); RK[g & 1] = *(const LAS f16x8*)(pk + 16 * (g + 2)); }
#pragma unroll
        for (int hf = 0; hf < 2; ++hf) {
            const f32x2 wh = hf ? w.zw : w.xy, bh = hf ? be.zw : be.xy;
            const f32x2 rh = (f32x2){(float)rk[2 * hf], (float)rk[2 * hf + 1]}, kh = (f32x2){(float)rk[4 + 2 * hf], (float)rk[5 + 2 * hf]};
            const int cp = 2 * g + hf;
#pragma unroll
            for (int r = 0; r < 4; ++r) {
                const f32x2 tu = fma2(kh, (f32x2){vv[r], vv[r]}, SU[r][cp] * wh), tp = SP[r][cp] * wh;
                SU[r][cp] = fma2(bh, (f32x2){saU[r], saU[r]}, tu);
                yU[r] = fma2(SU[r][cp], rh, yU[r]);
                SP[r][cp] = fma2(bh, (f32x2){saP[r], saP[r]}, tp);
                yP[r] = fma2(SP[r][cp], rh, yP[r]);
            }
        }
        CFENCE();
    }
    f32x4 yp, yu;
#pragma unroll
    for (int r = 0; r < 4; ++r) { yp[r] = quad_sum(yP[r].x + yP[r].y); yu[r] = quad_sum(yU[r].x + yU[r].y); }
    if (sub == 0) {
        *(LAS f16x4*)(wl + L::W + t * 256 + 8 * Q) = cvt4(yp);
        *(LAS f16x4*)(wl + L::W + t * 256 + 128 + 8 * Q) = cvt4(yu);
    }
}
__device__ __forceinline__ void scan_stage(const f16* ZR, int rowm1, LAS unsigned char* dst, int wave, int lane) {
    const char* g = (const char*)(ZR + (ptrdiff_t)rowm1 * SHW);
#pragma unroll
    for (int i = 0; i < 4; ++i) { const int blk = i * 8 + wave;
        __builtin_amdgcn_global_load_lds((const unsigned*)(g + (blk * 64 + lane) * 16), (LAS unsigned*)(dst + blk * 1024), 16, 0, 0); }
}
constexpr int SH64_P = 136;
__device__ __forceinline__ void scan_stage_w(const f16* ZR, int rowm1, int h, LAS unsigned char* dst, int lane) {
#pragma unroll
    for (int i = 0; i < 4; ++i) {
        int ci = i * 64 + lane; ci = ci < 216 ? ci : 215;
        const int row = ci / 24, seg = ci % 24;
        const f16* g = ZR + (ptrdiff_t)(rowm1 + row) * SHW + (seg >> 3) * RW + h * 64 + 8 * (seg & 7);
        __builtin_amdgcn_global_load_lds((const unsigned*)g, (LAS unsigned*)(dst + i * 1024), 16, 0, 0);
    }
}
__device__ __forceinline__ f32x4 zsw(const LAS f16* rw, const LAS unsigned char* prm, int h, int row, int tl, int a, int c4) {
    const f32x4 z = up4(*(const LAS f16x4*)(rw + (tl + 1) * 192 + a * 64 + c4));
    f32x4 pv = up4(*(const LAS f16x4*)(rw + tl * 192 + a * 64 + c4));
    if ((row & (SEQ - 1)) == 0) pv = (f32x4){0.f, 0.f, 0.f, 0.f};
    const f32x4 m = up4(*(const LAS f16x4*)(prm + PR_MU + 2 * (a * RW + h * 64 + c4)));
    return z + (pv - z) * m;
}
__device__ __forceinline__ void rwkv_prep8(const RwkvP& P, int h, int row0, const LAS f16* raw, const LAS unsigned char* prm, LAS unsigned char* wl, int lane, const f16x8 lw, const f16x8 aa) {
    typedef RL<8> L;
    const int tl = lane & 7, q = lane >> 3, row = row0 + tl;
    float ssq = 0.f, bon = 0.f;
#pragma unroll
    for (int hh = 0; hh < 2; ++hh) {
        const int c4 = 8 * q + 4 * hh, ch = h * 64 + c4;
        const f32x4 av = hh ? up8hi(aa) : up8lo(aa), lwv = hh ? up8hi(lw) : up8lo(lw);
        f32x4 w; w.x = __expf(lwv.x); w.y = __expf(lwv.y); w.z = __expf(lwv.z); w.w = __expf(lwv.w);
        const f32x4 rv = zsw(raw, prm, h, row, tl, 0, c4), kx = zsw(raw, prm, h, row, tl, 1, c4), vv = zsw(raw, prm, h, row, tl, 2, c4);
        const f32x4 kkv = kx * par4<false>(P.kk_, prm, PR_KK, ch);
        const f32x4 kp = kx * (1.0f + (av - 1.0f) * par4<false>(P.ka_, prm, PR_KA, ch));
        const f32x4 s2 = kkv * kkv; ssq += (s2.x + s2.y) + (s2.z + s2.w);
        const f32x4 b2 = rv * kp * par4<false>(P.rk_, prm, PR_RK, ch); bon += (b2.x + b2.y) + (b2.z + b2.w);
        *(LAS f32x4*)(wl + L::W + (tl * 64 + c4) * 4) = w;
        *(LAS f32x4*)(wl + L::AL + (tl * 64 + c4) * 4) = kkv;
        *(LAS f32x4*)(wl + L::BE + (tl * 64 + c4) * 4) = av;
        *(LAS f16x4*)(wl + L::RK + (tl * 64 + c4) * 4) = cvt4(rv);
        *(LAS f16x4*)(wl + L::RK + (tl * 64 + c4) * 4 + 8) = cvt4(kp);
        *(LAS f16x4*)(wl + L::V + (tl * 64 + c4) * 2) = cvt4(vv);
    }
    ssq += shfl_xor_l(ssq, 8, lane); bon += shfl_xor_l(bon, 8, lane); ssq += shfl_xor_l(ssq, 16, lane); bon += shfl_xor_l(bon, 16, lane); ssq += shfl_xor_l(ssq, 32, lane); bon += shfl_xor_l(bon, 32, lane);
    const float inv = rsqf_(fmaxf(ssq, 1e-24f));
    LDS_WAIT();
#pragma unroll
    for (int hh = 0; hh < 2; ++hh) {
        const int c4 = 8 * q + 4 * hh;
        const f32x4 kn = *(const LAS f32x4*)(wl + L::AL + (tl * 64 + c4) * 4) * inv, av = *(const LAS f32x4*)(wl + L::BE + (tl * 64 + c4) * 4);
        *(LAS f32x4*)(wl + L::AL + (tl * 64 + c4) * 4) = -kn;
        *(LAS f32x4*)(wl + L::BE + (tl * 64 + c4) * 4) = kn * av;
    }
    {   const f16x8 v8 = *(const LAS f16x8*)(wl + L::V + (tl * 64 + 8 * q) * 2);
        *(f16x8*)(P.YRA + (size_t)row * D + h * 64 + 8 * q) = cvt8(up8lo(v8) * bon, up8hi(v8) * bon); }
    CFENCE();
}
__device__ __forceinline__ void scan_unit_prompt(Frame& F, int l, int unit) {
    typedef RL<8> L;
    const int h = F.wave; int lane = F.lane; asm volatile("" : "+v"(lane)); const int tid = h * 64 + lane;
    const RwkvP P = rwkv_params(F, l);
    LAS unsigned char* wl = F.lds + h * L::SIZE;
    const int row0 = (unit >> 7) * SEQ + (unit & 127) * CH;
    f16* ysc = (f16*)(F.ws + WS_YSC) + ((size_t)unit * 8 + h) * 8192;
    f16* lws = WSP(f16, WS_MIX) + ((size_t)F.bid * 8 + h) * 8192;
    const LAS unsigned char* prm = F.lds + PRM_OFF;
    __syncthreads();
    {
        LAS unsigned char* pw_ = F.lds + PRM_OFF; const int t4 = 4 * tid;
        if (t4 < RW) { *(LAS f32x4*)(pw_ + PR_DB + 4 * t4) = *(const f32x4*)(P.dbase + t4); *(LAS f16x4*)(pw_ + PR_IB + 2 * t4) = cvt4(*(const f32x4*)(P.ibase + t4)); *(LAS f16x4*)(pw_ + PR_KK + 2 * t4) = cvt4(*(const f32x4*)(P.kk_ + t4));
                       *(LAS f16x4*)(pw_ + PR_KA + 2 * t4) = cvt4(*(const f32x4*)(P.ka_ + t4)); *(LAS f16x4*)(pw_ + PR_RK + 2 * t4) = cvt4(*(const f32x4*)(P.rk_ + t4)); }
        if (t4 < SHW) *(LAS f16x4*)(pw_ + PR_MU + 2 * t4) = cvt4(*(const f32x4*)(P.mu + t4));
    }
    {
        LAS f16* sh = (LAS f16*)F.lds;
        const int tk = tid >> 3, c16 = 16 * (tid & 7), row = row0 + tk, col = 3 * RW + c16;
#pragma unroll
        for (int hh = 0; hh < 2; ++hh) {
            const f16x8 z = *(const f16x8*)(P.ZR + (size_t)row * SHW + col + 8 * hh);
            f16x8 pv; if ((row & (SEQ - 1)) == 0) { for (int e = 0; e < 8; ++e) pv[e] = (f16)0.f; } else pv = *(const f16x8*)(P.ZR + (size_t)(row - 1) * SHW + col + 8 * hh);
            const f32x4 m0 = *(const f32x4*)(P.mu + col + 8 * hh), m1 = *(const f32x4*)(P.mu + col + 8 * hh + 4);
            f16x8 o;
#pragma unroll
            for (int e = 0; e < 8; ++e) { const float zz = (float)z[e], pp = (float)pv[e], mm = e < 4 ? m0[e & 3] : m1[e & 3]; o[e] = (f16)lora_act(zz + (pp - zz) * mm, c16); }
            *(LAS f16x8*)(sh + tk * SH64_P + c16 + 8 * hh) = o;
        }
    }
    LDS_WAIT(); __syncthreads();
    {
        const unsigned tl = lane & 15, q = lane >> 4;
        const f16* DUb = P.lora + (size_t)h * 64 * 64; const f16* IUb = DUb + 512 * 64;
        const unsigned wo = tl * 64u + 8u * q;
        f16x8 wd[4][2], wi[4][2];
#pragma unroll
        for (int nt = 0; nt < 4; ++nt)
#pragma unroll
            for (int kk = 0; kk < 2; ++kk) { wd[nt][kk] = *(const f16x8*)(DUb + (wo + (unsigned)(nt * 1024 + 32 * kk))); wi[nt][kk] = *(const f16x8*)(IUb + (wo + (unsigned)(nt * 1024 + 32 * kk))); }
#pragma unroll 1
        for (int tt = 0; tt < 4; ++tt) {
            const LAS f16* sh = (const LAS f16*)F.lds + (16 * tt + tl) * SH64_P + 8 * q;
            const f16x8 fd0 = *(const LAS f16x8*)(sh), fd1 = *(const LAS f16x8*)(sh + 32), fi0 = *(const LAS f16x8*)(sh + 64), fi1 = *(const LAS f16x8*)(sh + 96);
            const unsigned so = (16u * tt + tl) * 64u + 4u * q;
#pragma unroll
            for (int nt = 0; nt < 4; ++nt) {
                const int c4 = 16 * nt + 4 * q;
                f32x4 ad = (f32x4){0.f, 0.f, 0.f, 0.f}, ai = ad;
                ad = __builtin_amdgcn_mfma_f32_16x16x32_f16(wd[nt][0], fd0, ad, 0, 0, 0); ad = __builtin_amdgcn_mfma_f32_16x16x32_f16(wd[nt][1], fd1, ad, 0, 0, 0);
                ai = __builtin_amdgcn_mfma_f32_16x16x32_f16(wi[nt][0], fi0, ai, 0, 0, 0); ai = __builtin_amdgcn_mfma_f32_16x16x32_f16(wi[nt][1], fi1, ai, 0, 0, 0);
                const f32x4 lw = sig4(*(const LAS f32x4*)(prm + PR_DB + 4 * (h * 64 + c4)) + ad) * (-0.60653065971263342f);
                const f32x4 av = sig4(up4(*(const LAS f16x4*)(prm + PR_IB + 2 * (h * 64 + c4))) + ai);
                *(f16x4*)(lws + (so + 16u * nt)) = cvt4(lw);
                *(f16x4*)(lws + 4096 + (so + 16u * nt)) = cvt4(av);
            }
        }
    }
    VM_WAIT(); __syncthreads();
    LAS unsigned char* rawb = F.lds + RAW_OFF + h * 8192;
    scan_stage_w(P.ZR, row0 - 1, h, rawb, lane);
    f16x8 lw, aa;
    {   const unsigned lo = (unsigned)((lane & 7) * 64 + 8 * (lane >> 3));
        lw = *(const f16x8*)(lws + lo); aa = *(const f16x8*)(lws + 4096 + lo); }
    f32x2 SP[4][8], SU[4][8];
    { int l0 = lane; asm volatile("" : "+v"(l0));
      const int d0 = 4 * (l0 >> 2) - 16 * (l0 & 3);
#pragma unroll
      for (int r = 0; r < 4; ++r)
#pragma unroll
        for (int cp = 0; cp < 8; ++cp) { SP[r][cp] = (f32x2){(d0 + r == 2 * cp) ? 1.f : 0.f, (d0 + r == 2 * cp + 1) ? 1.f : 0.f}; SU[r][cp] = (f32x2){0.f, 0.f}; } }
    for (int g = 0; g < 8; ++g) {
        int lz = lane; asm volatile("" : "+v"(lz));
        VM_WAIT();
        if (g > 0) {
            const LAS unsigned char* yb = wl + L::W + (lz >> 3) * 256 + 16 * (lz & 7);
            const f16x8 y0 = *(const LAS f16x8*)yb, y1 = *(const LAS f16x8*)(yb + 128);
            f16* yo = ysc + (8 * (g - 1) + (lz >> 3)) * 64 + 8 * (lz & 7);
            *(f16x8*)yo = y0; *(f16x8*)(yo + 4096) = y1;
        }
        const LAS f16* raw = (const LAS f16*)(rawb + (g & 1) * 4096);
        if (g < 7) scan_stage_w(P.ZR, row0 + 8 * (g + 1) - 1, h, rawb + ((g + 1) & 1) * 4096, lz);
#ifdef PROBE_PREP
        const unsigned long long tq0 = __builtin_amdgcn_s_memrealtime();
#endif
        rwkv_prep8(P, h, row0 + 8 * g, raw, prm, wl, lz, lw, aa);
#ifdef PROBE_PREP
        LDS_WAIT(); F.pacc2 += __builtin_amdgcn_s_memrealtime() - tq0;
#endif
        if (g < 7) {
            const unsigned lo = (unsigned)((8 * (g + 1) + (lz & 7)) * 64 + 8 * (lz >> 3));
            lw = *(const f16x8*)(lws + lo); aa = *(const f16x8*)(lws + 4096 + lo);
        }
        LDS_WAIT();
#ifdef PROBE_STEPS
        const unsigned long long ts0 = __builtin_amdgcn_s_memrealtime();
#endif
        for (int t = 0; t < 8; ++t) scan_step_q(SP, SU, wl, t, lz >> 2, lz & 3);
#ifdef PROBE_STEPS
        F.pacc2 += __builtin_amdgcn_s_memrealtime() - ts0;
#endif
        LDS_WAIT();
    }
    {   const LAS unsigned char* yb = wl + L::W + (lane >> 3) * 256 + 16 * (lane & 7);
        const f16x8 y0 = *(const LAS f16x8*)yb, y1 = *(const LAS f16x8*)(yb + 128);
        f16* yo = ysc + (8 * 7 + (lane >> 3)) * 64 + 8 * (lane & 7);
        *(f16x8*)yo = y0; *(f16x8*)(yo + 4096) = y1; }
    float* pu = F.out + ((size_t)unit * 8 + h) * 8192;
    {
        const int Q = lane >> 2, sub = lane & 3;
        f16* pfh = (f16*)pu + (sub * 1024 + (Q >> 3) * 512 + (Q & 3) * 128 + 4 * ((Q >> 2) & 1));
#pragma unroll
        for (int c = 0; c < 16; ++c) *(f16x4*)(pfh + c * 8) = cvt4((f32x4){SP[0][c >> 1][c & 1], SP[1][c >> 1][c & 1], SP[2][c >> 1][c & 1], SP[3][c >> 1][c & 1]});
        float* uu = pu + 4096 + (4 * Q) * 64 + 16 * sub;
#pragma unroll
        for (int r = 0; r < 4; ++r)
#pragma unroll
            for (int j = 0; j < 4; ++j) *(f32x4*)(uu + r * 64 + 4 * j) = (f32x4){SU[r][2 * j].x, SU[r][2 * j].y, SU[r][2 * j + 1].x, SU[r][2 * j + 1].y};
    }
}
__device__ __forceinline__ void scan_unit_sample(Frame& F, int l, int b) {
    typedef RL<4> L;
    int lane = F.lane; asm volatile("" : "+v"(lane));
    const int h = F.wave;
    const RwkvP P = rwkv_params(F, l);
    LAS unsigned char* wl = F.lds + h * L::SIZE;
    LAS f16* sh = (LAS f16*)(F.lds + SHS_OFF);
    const int row0 = MP + 4 * b;
    __syncthreads();
    rwkv_prepA<true>(P, h, row0, nullptr, nullptr, sh, lane);
    LDS_WAIT(); __syncthreads();
    rwkv_prepB<true, 4>(P, h, row0, nullptr, nullptr, sh, wl, lane);
    asm volatile("" : "+v"(lane));
    float S[64];
    const float* s0 = F.in[2] + (((size_t)l * DECB + b) * 8 + h) * 4096 + lane * 64;
#pragma unroll
    for (int k = 0; k < 16; ++k) { const f32x4 t4 = *(const f32x4*)(s0 + 4 * k); S[4 * k] = t4.x; S[4 * k + 1] = t4.y; S[4 * k + 2] = t4.z; S[4 * k + 3] = t4.w; }
    LDS_WAIT(); VM_WAIT();
    const float lg = F.in[16][l * RW + h * 64 + lane], lb = F.in[17][l * RW + h * 64 + lane];
    f16* yp = P.YRA + (size_t)row0 * D + h * 64 + lane; const f16* gp = P.GG + (size_t)(row0 - MP) * RW + h * 64 + lane;
    float bv[4], gg[4];
#pragma unroll
    for (int t = 0; t < 4; ++t) { bv[t] = (float)yp[(size_t)t * D]; gg[t] = (float)gp[(size_t)t * RW]; }
#pragma unroll
    for (int t = 0; t < 4; ++t) {
        const float vv = (float)*(const LAS f16*)(wl + L::V + (t * 64 + lane) * 2);
        float ydummy, y; scan_step<false, 4>(S, S, wl, t, vv, ydummy, y);
        const float mu = wave_sum(y) * (1.f / 64.f), dv = y - mu, var = wave_sum(dv * dv) * (1.f / 64.f);
        yp[(size_t)t * D] = (f16)((dv * rsqf_(var + GN_EPS) * lg + lb + bv[t]) * gg[t]);
    }
    float* so = F.out + O_SWKV + (((size_t)l * DECB + b) * 8 + h) * 4096 + lane * 64;
#pragma unroll
    for (int k = 0; k < 16; ++k) *(f32x4*)(so + 4 * k) = (f32x4){S[4 * k], S[4 * k + 1], S[4 * k + 2], S[4 * k + 3]};
    LDS_WAIT();
}
struct SpStage { f16x8 a[8]; f32x4 u[4]; };
__device__ __forceinline__ void sp_load(SpStage& st, const float* pu, int lane, int uoff) {
    const f16* pf = (const f16*)pu + lane * 8;
#pragma unroll
    for (int f = 0; f < 8; ++f) st.a[f] = *(const f16x8*)(pf + f * 512);
#pragma unroll
    for (int I = 0; I < 4; ++I) st.u[I] = *(const f32x4*)(pu + uoff + 16 * I);
}
__device__ __forceinline__ void sp_step(const SpStage& st, f32x4 (&X)[4], float* pu, int uoff) {
    f16x8 xh[2];
#pragma unroll
    for (int s = 0; s < 2; ++s)
#pragma unroll
        for (int j = 0; j < 8; ++j) xh[s][j] = (f16)X[2 * s + (j >> 2)][j & 3];
#pragma unroll
    for (int I = 0; I < 4; ++I) {
        f32x4 a = st.u[I];
#pragma unroll
        for (int s = 0; s < 2; ++s) a = __builtin_amdgcn_mfma_f32_16x16x32_f16(st.a[I * 2 + s], xh[s], a, 0, 0, 0);
        X[I] = a; { const int q_ = (uoff >> 2) & 3; *(f16x4*)((f16*)(pu + 4096) + 2 * (uoff - 4096 - 4 * q_) + 16 * I + 4 * q_) = cvt4(a); }
    }
}
__device__ __forceinline__ void spass_task(Frame& F, int l, int task) {
    const int w = task & 3, h = (task >> 2) & 7, b = task >> 5, lane = F.lane, m = lane & 15, q = lane >> 4;
    const int uoff = 4096 + (16 * w + m) * 64 + 4 * q;
    f32x4 X[4];
#pragma unroll
    for (int J = 0; J < 4; ++J) X[J] = (f32x4){0.f, 0.f, 0.f, 0.f};
    float* pu0 = F.out + ((size_t)(b * NCH) * 8 + h) * 8192;
    constexpr size_t CS = 8 * 8192;
    SpStage s0, s1, s2, s3;
    sp_load(s0, pu0, lane, uoff); sp_load(s1, pu0 + CS, lane, uoff); sp_load(s2, pu0 + 2 * CS, lane, uoff); sp_load(s3, pu0 + 3 * CS, lane, uoff);
    for (int c = 0; c < NCH; c += 4) {
        float* pu = pu0 + (size_t)c * CS;
        sp_step(s0, X, pu, uoff);          if (c + 4 < NCH) sp_load(s0, pu + 4 * CS, lane, uoff);
        sp_step(s1, X, pu + CS, uoff);     if (c + 5 < NCH) sp_load(s1, pu + 5 * CS, lane, uoff);
        sp_step(s2, X, pu + 2 * CS, uoff); if (c + 6 < NCH) sp_load(s2, pu + 6 * CS, lane, uoff);
        sp_step(s3, X, pu + 3 * CS, uoff); if (c + 7 < NCH) sp_load(s3, pu + 7 * CS, lane, uoff);
    }
    float* so = F.out + O_PWKV + (((size_t)l * NB + b) * 8 + h) * 4096 + (16 * w + m) * 64 + 4 * q;
#pragma unroll
    for (int I = 0; I < 4; ++I) *(f32x4*)(so + 16 * I) = X[I];
}
constexpr int SPR = 12, SP_SLOT = 12288, SP_FLAG = SPR * SP_SLOT;
static_assert(SP_FLAG + 128 <= MISC_OFF, "state-pass ring");
__device__ __forceinline__ void spass_ring(Frame& F, int l, int task) {
    const int w = task & 3, h = (task >> 2) & 7, b = task >> 5;
    int lane = F.lane; asm volatile("" : "+v"(lane));
    const int m = lane & 15, q = lane >> 4;
    const int uoff = 4096 + (16 * w + m) * 64 + 4 * q;
    float* pu0 = F.out + ((size_t)(b * NCH) * 8 + h) * 8192;
    constexpr size_t CS = 8 * 8192;
    volatile LAS unsigned* ready = (volatile LAS unsigned*)(F.lds + SP_FLAG);
    volatile LAS unsigned* consumed = ready + 16;
    __syncthreads();
    if (F.tid < 32) ready[F.tid] = 0u;
    LDS_WAIT(); __syncthreads();
    if (F.wave == 0) {
        f32x4 X[4];
#pragma unroll
        for (int J = 0; J < 4; ++J) X[J] = (f32x4){0.f, 0.f, 0.f, 0.f};
        auto rdops = [&](SpStage& st, int c) {
            const LAS unsigned char* slot = F.lds + (c % SPR) * SP_SLOT + lane * 16;
#pragma unroll
            for (int f = 0; f < 8; ++f) st.a[f] = *(const LAS f16x8*)(slot + f * 1024);
#pragma unroll
            for (int I = 0; I < 4; ++I) st.u[I] = *(const LAS f32x4*)(slot + 8192 + I * 1024);
        };
        auto waitrdy = [&](unsigned fv, int c) {
#ifdef PROBE_SPW
            const unsigned long long tw0 = __builtin_amdgcn_s_memrealtime();
#endif
            for (int spin = 0; fv != (unsigned)(c + 1) && spin < (1 << 21); ++spin) { __builtin_amdgcn_s_sleep(1); fv = ready[c % SPR]; }
#ifdef PROBE_SPW
            F.pacc2 += __builtin_amdgcn_s_memrealtime() - tw0;
#endif
            asm volatile("" ::: "memory");
        };
        unsigned fv = ready[0];
        auto step = [&](const SpStage& st, SpStage& nx, int c) {
            unsigned fn = 0u;
            if (c + 1 < NCH) { waitrdy(fv, c + 1); rdops(nx, c + 1); if (c + 2 < NCH) fn = ready[(c + 2) % SPR]; }
            f16x8 xh[2];
#pragma unroll
            for (int s = 0; s < 2; ++s)
#pragma unroll
                for (int j = 0; j < 8; ++j) xh[s][j] = (f16)X[2 * s + (j >> 2)][j & 3];
            f32x4 a[4];
#pragma unroll
            for (int I = 0; I < 4; ++I) a[I] = __builtin_amdgcn_mfma_f32_16x16x32_f16(st.a[I * 2], xh[0], st.u[I], 0, 0, 0);
#pragma unroll
            for (int I = 0; I < 4; ++I) a[I] = __builtin_amdgcn_mfma_f32_16x16x32_f16(st.a[I * 2 + 1], xh[1], a[I], 0, 0, 0);
            float* pu = pu0 + (size_t)c * CS;
#pragma unroll
            for (int I = 0; I < 4; ++I) { X[I] = a[I]; *(f16x4*)((f16*)(pu + 4096) + 2 * (uoff - 4096 - 4 * q) + 16 * I + 4 * q) = cvt4(a[I]); }
            LDS_WAIT();
            if (lane == 0 && c + 1 < NCH) *consumed = (unsigned)(c + 2);
            fv = fn;
        };
        SpStage s0, s1;
        waitrdy(fv, 0); rdops(s0, 0); fv = ready[1 % SPR]; LDS_WAIT(); if (lane == 0) *consumed = 1u;
#pragma unroll 1
        for (int c = 0; c < NCH; c += 2) { step(s0, s1, c); step(s1, s0, c + 1); }
        float* so = F.out + O_PWKV + (((size_t)l * NB + b) * 8 + h) * 4096 + (16 * w + m) * 64 + 4 * q;
#pragma unroll
        for (int I = 0; I < 4; ++I) *(f32x4*)(so + 16 * I) = X[I];
    } else {
        const int lw = F.wave - 1;
        auto issue = [&](int c) {
            const float* pu = pu0 + (size_t)c * CS; const f16* pf = (const f16*)pu + lane * 8;
            LAS unsigned char* slot = F.lds + (c % SPR) * SP_SLOT;
#pragma unroll
            for (int f = 0; f < 8; ++f) __builtin_amdgcn_global_load_lds((const unsigned*)(pf + f * 512), (LAS unsigned*)(slot + f * 1024), 16, 0, 0);
#pragma unroll
            for (int I = 0; I < 4; ++I) __builtin_amdgcn_global_load_lds((const unsigned*)(pu + uoff + 16 * I), (LAS unsigned*)(slot + 8192 + I * 1024), 16, 0, 0);
        };
        issue(lw);
#pragma unroll 1
        for (int c = lw; c < NCH; c += 7) {
            const int cn = c + 7;
            if (cn < NCH) {
                if (cn >= SPR) for (int spin = 0; (int)*consumed < cn - SPR + 1 && spin < (1 << 21); ++spin) __builtin_amdgcn_s_sleep(1);
                issue(cn);
                asm volatile("s_waitcnt vmcnt(12)" ::: "memory");
            } else VM_WAIT();
            if (lane == 0) ready[c % SPR] = (unsigned)(c + 1);
            LDS_WAIT();
        }
    }
}
constexpr int SG_P = 136;
__device__ __forceinline__ void combine_unit(Frame& F, int l, int unit) {
    const int h = F.wave, c = unit & 127, b = unit >> 7, lane = F.lane, ql = lane & 31, hf = lane >> 5;
    const int row0 = b * SEQ + c * CH;
    const f16* ZR = WSP(f16, WS_ZR);
    LAS f16* SG = (LAS f16*)F.lds;
    __syncthreads();
    {
        const int tk = F.tid >> 3, c16 = 3 * RW + 128 + 16 * (F.tid & 7), row = row0 + tk;
        const float* mu = F.in[7] + (size_t)l * SHW + c16;
#pragma unroll
        for (int hh = 0; hh < 2; ++hh) {
            const f16x8 z = *(const f16x8*)(ZR + (size_t)row * SHW + c16 + 8 * hh);
            f16x8 pv; if ((row & (SEQ - 1)) == 0) { for (int e = 0; e < 8; ++e) pv[e] = (f16)0.f; } else pv = *(const f16x8*)(ZR + (size_t)(row - 1) * SHW + c16 + 8 * hh);
            const f32x4 m0 = *(const f32x4*)(mu + 8 * hh), m1 = *(const f32x4*)(mu + 8 * hh + 4);
            f16x8 o;
#pragma unroll
            for (int e = 0; e < 8; ++e) { const float zz = (float)z[e], pp = (float)pv[e], mm = e < 4 ? m0[e & 3] : m1[e & 3]; o[e] = (f16)sigmoidf_(zz + (pp - zz) * mm); }
            *(LAS f16x8*)(SG + tk * SG_P + 16 * (F.tid & 7) + 8 * hh) = o;
        }
    }
    LDS_WAIT(); __syncthreads();
    const f16* ysc = (const f16*)(F.ws + WS_YSC) + ((size_t)unit * 8 + h) * 8192;
    f32x16 acc[2][2];
#pragma unroll
    for (int vt = 0; vt < 2; ++vt)
#pragma unroll
        for (int tt = 0; tt < 2; ++tt)
#pragma unroll
            for (int i = 0; i < 16; ++i) acc[vt][tt][i] = 0.f;
    if (c > 0) {
        const float* Sc = F.out + ((size_t)(unit - 1) * 8 + h) * 8192 + 4096;
#pragma unroll
        for (int kk = 0; kk < 4; ++kk) {
            f16x8 sf[2], yf[2];
#pragma unroll
            for (int vt = 0; vt < 2; ++vt) sf[vt] = *(const f16x8*)((const f16*)Sc + (32 * vt + ql) * 128 + 16 * kk + 8 * hf);
#pragma unroll
            for (int tt = 0; tt < 2; ++tt) yf[tt] = *(const f16x8*)(ysc + (32 * tt + ql) * 64 + 16 * kk + 8 * hf);
#pragma unroll
            for (int vt = 0; vt < 2; ++vt)
#pragma unroll
                for (int tt = 0; tt < 2; ++tt) acc[vt][tt] = __builtin_amdgcn_mfma_f32_32x32x16_f16(sf[vt], yf[tt], acc[vt][tt], 0, 0, 0);
        }
    }
    f16* YRA = WSP(f16, WS_YRA);
    const f16* GU = (const f16*)(F.ws + WS_LORA + (size_t)l * LORA_STRIDE) + 2 * 512 * 64 + (size_t)(h * 64 + ql) * 128 + 8 * hf;
    const float* lg = F.in[16] + l * RW + h * 64; const float* lb = F.in[17] + l * RW + h * 64;
#pragma unroll
    for (int tt = 0; tt < 2; ++tt) {
        const int t = 32 * tt + ql, row = row0 + t;
        f32x16 gac[2];
#pragma unroll
        for (int vt = 0; vt < 2; ++vt)
#pragma unroll
            for (int i = 0; i < 16; ++i) gac[vt][i] = 0.f;
#pragma unroll
        for (int kk = 0; kk < 8; ++kk) {
            const f16x8 gf = *(const LAS f16x8*)(SG + t * SG_P + 16 * kk + 8 * hf);
#pragma unroll
            for (int vt = 0; vt < 2; ++vt) gac[vt] = __builtin_amdgcn_mfma_f32_32x32x16_f16(*(const f16x8*)(GU + (size_t)vt * 32 * 128 + 16 * kk), gf, gac[vt], 0, 0, 0);
        }
        float s = 0.f;
#pragma unroll
        for (int vt = 0; vt < 2; ++vt)
#pragma unroll
            for (int g4 = 0; g4 < 4; ++g4) { const f32x4 yu = up4(*(const f16x4*)(ysc + 4096 + t * 64 + 32 * vt + 8 * g4 + 4 * hf));
                acc[vt][tt][4 * g4] += yu.x; acc[vt][tt][4 * g4 + 1] += yu.y; acc[vt][tt][4 * g4 + 2] += yu.z; acc[vt][tt][4 * g4 + 3] += yu.w;
                s += (acc[vt][tt][4 * g4] + acc[vt][tt][4 * g4 + 1]) + (acc[vt][tt][4 * g4 + 2] + acc[vt][tt][4 * g4 + 3]); }
        s += shfl_xor_l(s, 32, lane);
        const float mu = s * (1.f / 64.f); float qv = 0.f;
#pragma unroll
        for (int vt = 0; vt < 2; ++vt)
#pragma unroll
            for (int i = 0; i < 16; ++i) { const float d = acc[vt][tt][i] - mu; qv += d * d; }
        qv += shfl_xor_l(qv, 32, lane);
        const float rstd = rsqf_(qv * (1.f / 64.f) + GN_EPS);
#pragma unroll
        for (int vt = 0; vt < 2; ++vt)
#pragma unroll
            for (int g4 = 0; g4 < 4; ++g4) {
                const int v = 32 * vt + 8 * g4 + 4 * hf;
                const f32x4 y = (f32x4){acc[vt][tt][4 * g4], acc[vt][tt][4 * g4 + 1], acc[vt][tt][4 * g4 + 2], acc[vt][tt][4 * g4 + 3]};
                const f32x4 gg = (f32x4){gac[vt][4 * g4], gac[vt][4 * g4 + 1], gac[vt][4 * g4 + 2], gac[vt][4 * g4 + 3]};
                f16* yp = YRA + (size_t)row * D + h * 64 + v;
                const f32x4 bv = up4(*(const f16x4*)yp);
                *(f16x4*)yp = cvt4(((y - mu) * rstd * *(const f32x4*)(lg + v) + *(const f32x4*)(lb + v) + bv) * gg);
            }
    }
}

#ifndef MK_PER_PHASE
#define MK_PER_PHASE 0
#endif
constexpr int NPHASE = 1 + DEPTH * 10;
struct KArgs { Args a; double invf[32]; };
__global__ void __launch_bounds__(NTHR, 2) mk_fwd(KArgs ka) {
    extern __shared__ __attribute__((aligned(16))) unsigned char lds_raw[];
    Frame F;
    F.lds = (LAS unsigned char*)lds_raw;
    F.tid = threadIdx.x; F.lane = F.tid & 63; F.wave = __builtin_amdgcn_readfirstlane(F.tid >> 6);
    F.G = gridDim.x; F.bid = blockIdx.x; F.gw = F.bid * NWAVES + F.wave; F.NGW = F.G * NWAVES;
    F.in = ka.a.in; F.out = ka.a.out; F.ws = ka.a.ws; F.pacc2 = 0;
    volatile LAS unsigned* MISC = (volatile LAS unsigned*)(F.lds + MISC_OFF);
    if (F.tid < 64) MISC[F.tid] = 0u;
    __syncthreads();
    XcdBarrier bar = xcd_barrier_post((unsigned*)(F.ws + WS_CTL) + CW_BAR, MISC + 8);
    const int lo = ka.a.ph_lo, hi = ka.a.ph_hi;
    int ph = 0;
#ifndef PROBE_SEL
#define PROBE_SEL 0
#endif
    unsigned long long pacc = 0, pt0 = 0;
#define TICK(mask) do { if (PROBE_SEL & (mask)) pt0 = __builtin_amdgcn_s_memrealtime(); } while (0)
#define TOCK(mask) do { if (PROBE_SEL & (mask)) pacc += __builtin_amdgcn_s_memrealtime() - pt0; } while (0)
#define PHASE_BEGIN fresh_tid(F); if (lo <= ph && ph < hi) { { \
        size_t _z = 0; int _b = blockIdx.x; asm volatile("" : "+s"(_z), "+s"(_b)); F.out = ka.a.out + _z; F.ws = ka.a.ws + _z; F.bid = _b; F.gw = _b * NWAVES + F.wave; }
#define PHASE_END   if (ph + 1 < hi) xcd_barrier(bar, F.wave == 0 && fresh_lane() == 0); } ++ph;

    TICK(1); PHASE_BEGIN prologue(F, ka.invf); PHASE_END TOCK(1);

    for (int l = 0; l < DEPTH; ++l) {
        f16* XH = WSP(f16, WS_XH); f16* YRA = WSP(f16, WS_YRA); f16* MIX = WSP(f16, WS_MIX); f16* HB = WSP(f16, WS_H);
        const f16* WIN = WSP(f16, WS_WIN); const f16* WBR = WSP(f16, WS_WBR); const f16* WOUT = WSP(f16, WS_WOUT); const f16* WUP = WSP(f16, WS_WUP); const f16* WDN = WSP(f16, WS_WDN);
        TICK(2); PHASE_BEGIN {
            const EpiG1 e{WSP(f16, WS_ZR), YRA, WSP(f16, WS_KB), WSP(f16, WS_VB), WSP(f32x2, WS_ROPE), F.out, l, WSP(f16, WS_GRS), WSP(f16, WS_GAS)};
            const SchedG1Z SZ{XH, WIN, F.G, F.bid};
            pg8::gemm_phase(F.lds, D, D, SZ, EpiBig16<EpiG1>{e}, F.tid);
            const SchedG1R SR{XH, WIN, F.G, (F.bid + 34) % F.G};
            pg8::gemm_phase(F.lds, D, D, SR, EpiBigR<EpiG1>{e}, F.tid);
            if (F.G == 256) {
                const EpiMix eg{WSP(f16, WS_GG), WSP(f16, WS_GG), WSP(f16, WS_GRS), WSP(f16, WS_GAS), WSP(f16, WS_GG)};
                const SchedGate SG{XH, WIN, F.bid >= 164 ? F.bid - 164 : -1, 0};
                pg8::gemm_phase(F.lds, D, D, SG, EpiBig16<EpiMix>{eg}, F.tid);
            }
        } PHASE_END TOCK(2);
        const bool mix_early = F.G >= 128, pre_gate = F.G == 256;
        TICK(4); PHASE_BEGIN {
            TICK(2048); for (int u = F.bid; u < NB * NCH; u += F.G) scan_unit_prompt(F, l, u);
            __syncthreads(); TOCK(2048); fresh_tid(F);
            TICK(4096); if (!mix_early) for (int u = F.bid; u < NB * 64 * 2; u += F.G) attn_prompt_unit(F, l, u);
            __syncthreads(); TOCK(4096); fresh_tid(F);
            TICK(8192); for (int u = (F.bid + F.G - 64) % F.G; u < DECB; u += F.G) scan_unit_sample(F, l, u);
            __syncthreads(); TOCK(8192); fresh_tid(F);
            for (int t = ((F.bid + F.G - 32) % F.G) * NWAVES + F.wave; t < DECB * 2; t += F.NGW) attn_sample_task(F, l, t);
            if (F.G == 256 && (F.bid < 32 || F.bid >= 192)) {
                const int idx = F.bid < 32 ? F.bid : F.bid - 160;
                convert_layer_weights(F, l, 1, idx * NWAVES + F.wave, 96 * NWAVES);
            }
            const size_t gt = (size_t)F.bid * NTHR + F.tid, NT = (size_t)F.G * NTHR; constexpr int PER = (WBUF - DECT) * 128 / 4;
            for (size_t i = gt; i < (size_t)2 * DECB * PER; i += NT) {
                const int kv = (int)(i / ((size_t)DECB * PER)), r = (int)(i % ((size_t)DECB * PER)), b = r / PER, e = (r % PER) * 4;
                const float* src = F.in[4 + kv] + ((size_t)l * DECB + b) * WBUF * 128 + DECT * 128 + e;
                float* dst = F.out + (kv ? O_SV : O_SK) + ((size_t)l * DECB + b) * WBUF * 128 + e;
                *(f32x4*)dst = *(const f32x4*)src;
            }
        } PHASE_END TOCK(4);
        TICK(8); PHASE_BEGIN {
            if (!mix_early || F.bid < 64) {
#ifdef PROBE_SP
                const unsigned long long tq0 = __builtin_amdgcn_s_memrealtime();
#endif
                if (mix_early) spass_ring(F, l, F.bid);
                else for (int t = F.bid + F.G * F.wave; t < NB * 8 * 4; t += F.G * NWAVES) spass_task(F, l, t);
#ifdef PROBE_SP
                VM_WAIT(); F.pacc2 += __builtin_amdgcn_s_memrealtime() - tq0;
#endif
            }
            else {
                const EpiMix e{MIX, WSP(f16, WS_ZR), WSP(f16, WS_GRS), WSP(f16, WS_GAS), WSP(f16, WS_GG)};
                const SchedMix S{XH, YRA, WIN, WBR, F.G - 64, F.bid - 64, 0, 1, 0};
                pg8::gemm_phase(F.lds, D, D, S, EpiBig16<EpiMix>{e}, F.tid);
                __syncthreads(); fresh_tid(F);
                if (F.bid >= 72) for (int u = F.bid - 72; u < NB * 64 * 2; u += F.G - 72) attn_prompt_unit(F, l, u);
                if (pre_gate) {
                    __syncthreads(); fresh_tid(F);
                    const SchedGate SG{XH, WIN, F.bid >= 92 ? F.bid - 92 : -1, GHP};
                    pg8::gemm_phase(F.lds, D, D, SG, EpiBig16<EpiMix>{e}, F.tid);
                }
            }
        } PHASE_END TOCK(8);
        TICK(16); PHASE_BEGIN { for (int u = F.bid; u < NB * NCH; u += F.G) combine_unit(F, l, u); } PHASE_END TOCK(16);
        TICK(32); PHASE_BEGIN {
            const EpiMix e{MIX, WSP(f16, WS_ZR), WSP(f16, WS_GRS), WSP(f16, WS_GAS), pre_gate ? WSP(f16, WS_GG) : MIX};
            const SchedMix S{XH, YRA, WIN, WBR, F.G, F.bid, -1, mix_early ? 0 : 1, pre_gate ? 1 : 0};
            pg8::gemm_phase(F.lds, D, D, S, EpiBig16<EpiMix>{e}, F.tid);
        } PHASE_END TOCK(32);
        TICK(64); PHASE_BEGIN {
            const EpiRes e{XH, WSP(float, WS_SLAB)};
            const SchedSplit S{MIX, WOUT, D, D, 4, F.G, F.bid};
            pg8::gemm_phase(F.lds, D, D, S, EpiBig16<EpiRes>{e}, F.tid);
        } PHASE_END TOCK(64);
        TICK(128); PHASE_BEGIN ln_rows(F, F.in[22] + (size_t)l * D, F.in[23] + (size_t)l * D, false, 4); PHASE_END TOCK(128);
        TICK(256); PHASE_BEGIN {
            const EpiUp e{HB};
            const SchedPlain S{XH, WUP, D, D, M / 256, 16, 16, F.G, F.bid};
            pg8::gemm_phase(F.lds, D, D, S, EpiBig16<EpiUp>{e}, F.tid);
        } PHASE_END TOCK(256);
        TICK(512); PHASE_BEGIN {
            const EpiRes e{XH, WSP(float, WS_SLAB)};
            const SchedSplit S{HB, WDN, FF, FF, 8, F.G, F.bid};
            pg8::gemm_phase(F.lds, FF, FF, S, EpiBig16<EpiRes>{e}, F.tid);
        } PHASE_END TOCK(512);
        TICK(1024); PHASE_BEGIN {
            ln_rows(F, F.in[26] + (size_t)l * D, F.in[27] + (size_t)l * D, l == DEPTH - 1, 8);
            if (l + 1 < DEPTH) { __syncthreads(); convert_layer_weights(F, l + 1, F.G == 256 ? 0 : 2, F.gw, F.NGW); }
        } PHASE_END TOCK(1024);
    }
#if defined(PROBE_PREP) || defined(PROBE_STEPS) || defined(PROBE_SP) || defined(PROBE_SPW)
    pacc = F.pacc2;
#endif
    if (PROBE_SEL && blockIdx.x == 0) { const unsigned long long te = __builtin_amdgcn_s_memrealtime(); while (__builtin_amdgcn_s_memrealtime() - te < 4ull * pacc) __builtin_amdgcn_s_sleep(32); }
}

extern "C" void kernel_launch(void* const* d_in, const int* in_sizes, int n_in, void* d_out, int out_size, void* d_ws, size_t ws_size, hipStream_t stream) {
    static int grid = 0;
    if (grid == 0) {
        if (n_in != 28 || (size_t)out_size != O_END || ws_size < WS_END) fprintf(stderr, "kernel_launch: unexpected shapes: n_in %d out %d (want %zu) ws %zu (want >= %zu)\n", n_in, out_size, (size_t)O_END, ws_size, (size_t)WS_END);
        if (n_in != 28 || ws_size < WS_END) { grid = -1; return; }
        int dev = 0, cus = 0, per_cu = 0;
        if (hipGetDevice(&dev) != hipSuccess || hipDeviceGetAttribute(&cus, hipDeviceAttributeMultiprocessorCount, dev) != hipSuccess) { grid = -1; return; }
        if (hipFuncSetAttribute((const void*)mk_fwd, hipFuncAttributeMaxDynamicSharedMemorySize, LDS_BYTES) != hipSuccess) { fprintf(stderr, "kernel_launch: hipFuncSetAttribute failed\n"); grid = -1; return; }
        if (hipOccupancyMaxActiveBlocksPerMultiprocessor(&per_cu, (const void*)mk_fwd, NTHR, LDS_BYTES) != hipSuccess || per_cu < 1) fprintf(stderr, "kernel_launch: occupancy query says %d\n", per_cu);
        (void)hipGetLastError();
        grid = cus;
    }
    if (grid < 0) return;
    if (hipMemsetAsync((char*)d_ws + WS_CTL, 0, CTL_ZERO_BYTES, stream) != hipSuccess) return;
    KArgs ka{};
    for (int i = 0; i < 28; ++i) ka.a.in[i] = (const float*)d_in[i];
    ka.a.out = (float*)d_out; ka.a.ws = (unsigned char*)d_ws;
    for (int d = 0; d < 32; ++d) ka.invf[d] = pow(10000.0, -(double)d / 32.0);
#if MK_PER_PHASE
    for (int p = 0; p < NPHASE; ++p) { ka.a.ph_lo = p; ka.a.ph_hi = p + 1; ka.a.li = 0; hipLaunchKernelGGL(mk_fwd, dim3(grid), dim3(NTHR), LDS_BYTES, stream, ka); }
#else
    ka.a.ph_lo = 0; ka.a.ph_hi = NPHASE; ka.a.li = 0;
    hipLaunchKernelGGL(mk_fwd, dim3(grid), dim3(NTHR), LDS_BYTES, stream, ka);
#endif
}
```

```cpp
#include <hip/hip_runtime.h>
#include <cstdio>
#include <cstdint>

#define LAS __attribute__((address_space(3)))
#define GAS __attribute__((address_space(1)))
typedef _Float16 f16;
typedef _Float16 f16x2 __attribute__((ext_vector_type(2)));
typedef _Float16 f16x4 __attribute__((ext_vector_type(4)));
typedef _Float16 f16x8 __attribute__((ext_vector_type(8)));
typedef float f32x2 __attribute__((ext_vector_type(2)));
typedef float f32x4 __attribute__((ext_vector_type(4)));
typedef float f32x2 __attribute__((ext_vector_type(2)));
typedef float f32x16 __attribute__((ext_vector_type(16)));
typedef unsigned u32x2 __attribute__((ext_vector_type(2)));
typedef unsigned u32x4 __attribute__((ext_vector_type(4)));

constexpr int D = 1024, SEQ = 8192, NB = 2, DEPTH = 2, DECB = 128, DECT = 4, PAST = 8192;
constexpr int MP = NB * SEQ, MS = DECB * DECT, M = MP + MS;
constexpr int RW = 512, SHW = 1792, INW = 4608, FF = 4096, WBUF = 128;
constexpr int OQ = 1792, OK_ = 2304, OV = 2432, OGR = 2560, OGA = 3584;
constexpr float ALPHA = 1.4142135623730951f;
constexpr float LN_EPS = 1e-5f, GN_EPS = 64e-5f;
constexpr int NWAVES = 8, NTHR = 512;
constexpr int CH = 64;
constexpr int NCH = SEQ / CH;

constexpr size_t MiB = 1u << 20;
constexpr size_t WS_CTL = 0, CTL_ZERO_BYTES = 1 * MiB;
constexpr size_t WS_ROPE = 1 * MiB;
constexpr size_t WS_LORA = 4 * MiB;
constexpr size_t LORA_STRIDE = 256 * 1024;
constexpr size_t WS_WIN = 5 * MiB, WS_WBR = 14 * MiB, WS_WOUT = 16 * MiB, WS_WUP = 18 * MiB, WS_WDN = 26 * MiB;
constexpr size_t WS_XH = 34 * MiB;
constexpr size_t WS_ZR = 67 * MiB;
constexpr size_t WS_YRA = 125 * MiB;
constexpr size_t WS_KB = 158 * MiB, WS_VB = 163 * MiB;
constexpr size_t WS_GG = 168 * MiB;
constexpr size_t WS_MIX = 185 * MiB;
constexpr size_t WS_YSC = 218 * MiB;
constexpr size_t WS_H = 67 * MiB;
constexpr size_t WS_GRS = 250 * MiB, WS_GAS = 251 * MiB;
constexpr size_t WS_GGS = 252 * MiB;
constexpr size_t WS_SLAB = WS_YSC;
constexpr size_t WS_END = 256 * MiB;
static_assert(WS_YSC + 32 * MiB <= WS_END && WS_H + (size_t)M * FF * 2 <= WS_YSC + 32 * MiB, "ws map");

constexpr size_t O_YP = 0, O_YS = O_YP + (size_t)MP * D, O_PWKV = O_YS + (size_t)MS * D, O_PSH = O_PWKV + (size_t)DEPTH * NB * 8 * 64 * 64,
    O_PK = O_PSH + (size_t)DEPTH * NB * SHW, O_PV = O_PK + (size_t)DEPTH * NB * WBUF * 128, O_SWKV = O_PV + (size_t)DEPTH * NB * WBUF * 128,
    O_SSH = O_SWKV + (size_t)DEPTH * DECB * 8 * 64 * 64, O_SK = O_SSH + (size_t)DEPTH * DECB * SHW, O_SV = O_SK + (size_t)DEPTH * DECB * WBUF * 128,
    O_END = O_SV + (size_t)DEPTH * DECB * WBUF * 128;

constexpr int CW_BAR = 4096;

constexpr int LDS_BYTES = 159744;
constexpr int MISC_OFF = 159232;

#define RLX_AGENT __ATOMIC_RELAXED, __HIP_MEMORY_SCOPE_AGENT
#define LDS_WAIT() asm volatile("s_waitcnt lgkmcnt(0)" ::: "memory")
#define VM_WAIT() asm volatile("s_waitcnt vmcnt(0)" ::: "memory")
__device__ __forceinline__ f16x4 cvt4(f32x4 v) { f16x4 r; r.x = (f16)v.x; r.y = (f16)v.y; r.z = (f16)v.z; r.w = (f16)v.w; return r; }
__device__ __forceinline__ f16x8 cvt8(f32x4 a, f32x4 b) { f16x8 r; r[0] = (f16)a.x; r[1] = (f16)a.y; r[2] = (f16)a.z; r[3] = (f16)a.w; r[4] = (f16)b.x; r[5] = (f16)b.y; r[6] = (f16)b.z; r[7] = (f16)b.w; return r; }
__device__ __forceinline__ f32x4 up8lo(f16x8 v) { return (f32x4){(float)v[0], (float)v[1], (float)v[2], (float)v[3]}; }
__device__ __forceinline__ f32x4 up8hi(f16x8 v) { return (f32x4){(float)v[4], (float)v[5], (float)v[6], (float)v[7]}; }
__device__ __forceinline__ f32x4 up4(f16x4 v) { f32x4 r; r.x = (float)v.x; r.y = (float)v.y; r.z = (float)v.z; r.w = (float)v.w; return r; }
__device__ __forceinline__ float rcpf_(float x) { return __builtin_amdgcn_rcpf(x); }
__device__ __forceinline__ float rsqf_(float x) { return __builtin_amdgcn_rsqf(x); }
__device__ __forceinline__ float sigmoidf_(float x) { return rcpf_(1.0f + __expf(-x)); }
__device__ __forceinline__ float shfl_xor_l(float v, int mask, int lane) { return __builtin_bit_cast(float, __builtin_amdgcn_ds_bpermute((lane ^ mask) << 2, __builtin_bit_cast(int, v))); }
__device__ __forceinline__ float wave_sum(float v) {
    int x;
    x = __builtin_amdgcn_update_dpp(0, __builtin_bit_cast(int, v), 0x111, 0xf, 0xf, true); v += __builtin_bit_cast(float, x);
    x = __builtin_amdgcn_update_dpp(0, __builtin_bit_cast(int, v), 0x112, 0xf, 0xf, true); v += __builtin_bit_cast(float, x);
    x = __builtin_amdgcn_update_dpp(0, __builtin_bit_cast(int, v), 0x114, 0xf, 0xf, true); v += __builtin_bit_cast(float, x);
    x = __builtin_amdgcn_update_dpp(0, __builtin_bit_cast(int, v), 0x118, 0xf, 0xf, true); v += __builtin_bit_cast(float, x);
    x = __builtin_amdgcn_update_dpp(0, __builtin_bit_cast(int, v), 0x142, 0xa, 0xf, true); v += __builtin_bit_cast(float, x);
    x = __builtin_amdgcn_update_dpp(0, __builtin_bit_cast(int, v), 0x143, 0xc, 0xf, true); v += __builtin_bit_cast(float, x);
    return __builtin_bit_cast(float, __builtin_amdgcn_readlane(__builtin_bit_cast(int, v), 63));
}
__device__ __forceinline__ float wave_max(float v) {
#pragma unroll
    for (int o = 1; o < 64; o <<= 1) v = fmaxf(v, __shfl_xor(v, o));
    return v;
}

#define XB_TMO      128
#define XB_XCNT(j)  (256  + 64 * (j))
#define XB_XSUB(j)  (1280 + 64 * (j))
#define XB_XGEN(j)  (2304 + 64 * (j))
#define XB_TOP      3328
#define XB_TOPGEN   3392
#define XCD_BAR_WORDS 3456
#define XB_SPIN_CAP (1u << 20)
__device__ __forceinline__ unsigned xb_ld(unsigned* p)              { return __hip_atomic_load(p, __ATOMIC_RELAXED, __HIP_MEMORY_SCOPE_AGENT); }
__device__ __forceinline__ unsigned xb_add(unsigned* p, unsigned v) { return __hip_atomic_fetch_add(p, v, __ATOMIC_RELAXED, __HIP_MEMORY_SCOPE_AGENT); }
__device__ __forceinline__ unsigned xb_xcc_id() { return (unsigned)__builtin_amdgcn_s_getreg((3 << 11) | 20) & 0xFu; }
#define XB_SPIN(cond, bar) do { unsigned _sp = 0; while (cond) { __builtin_amdgcn_s_sleep(1); \
    if ((++_sp & 255u) == 0u) { if (xb_ld(&(bar)[XB_TMO])) break; if (_sp > XB_SPIN_CAP) { atomicAdd(&(bar)[XB_TMO], 1u); break; } } } } while (0)
struct XcdBarrier { unsigned* bar; unsigned x; volatile LAS unsigned* st; };
__device__ __forceinline__ XcdBarrier xcd_barrier_post(unsigned* bar, volatile LAS unsigned* st) {
    XcdBarrier b; b.bar = bar; b.x = xb_xcc_id(); b.st = st;
    if (threadIdx.x == 0) (void)xb_add(&bar[XB_XCNT(b.x)], 1u);
    return b;
}
__device__ __forceinline__ void xcd_barrier_complete(unsigned* bar, unsigned x, unsigned& nloc, unsigned& nx) {
    const unsigned G = gridDim.x * gridDim.y * gridDim.z;
    unsigned sum, cnt, mine, sp = 0u;
    for (;;) {
        sum = 0u; cnt = 0u; mine = 0u;
#pragma unroll
        for (unsigned j = 0; j < 16; ++j) { const unsigned c = xb_ld(&bar[XB_XCNT(j)]); sum += c; cnt += (c > 0u) ? 1u : 0u; mine = (j == x) ? c : mine; }
        if (sum == G) break;
        __builtin_amdgcn_s_sleep(1);
        if ((++sp & 255u) == 0u) { if (xb_ld(&bar[XB_TMO])) break; if (sp > XB_SPIN_CAP) { atomicAdd(&bar[XB_TMO], 1u); break; } }
    }
    nloc = mine > 0u ? mine : 1u; nx = cnt > 0u ? cnt : 1u;
}
__device__ __forceinline__ void xcd_barrier(const XcdBarrier& b, bool leader) {
    asm volatile("s_waitcnt vmcnt(0)" ::: "memory");
    __syncthreads();
    if (leader) {
        unsigned* bar = b.bar;
        __builtin_amdgcn_s_waitcnt(0);
        unsigned nloc = b.st[0], nx = b.st[1];
        if (nloc == 0u) { xcd_barrier_complete(bar, b.x, nloc, nx); b.st[0] = nloc; b.st[1] = nx; }
        const unsigned old = xb_add(&bar[XB_XSUB(b.x)], 1u);
        const unsigned gen = old / nloc;
        if (old + 1u == (gen + 1u) * nloc) {
            __builtin_amdgcn_fence(__ATOMIC_RELEASE, "agent");
            asm volatile("s_waitcnt vmcnt(0)" ::: "memory");
            const unsigned og = xb_add(&bar[XB_TOP], 1u);
            const unsigned tg = og / nx;
            if (og + 1u == (tg + 1u) * nx) xb_add(&bar[XB_TOPGEN], 1u);
            else XB_SPIN(xb_ld(&bar[XB_TOPGEN]) == tg, bar);
            __builtin_amdgcn_fence(__ATOMIC_ACQUIRE, "agent");
            xb_add(&bar[XB_XGEN(b.x)], 1u);
            asm volatile("s_waitcnt vmcnt(0)" ::: "memory");
        } else {
            XB_SPIN(xb_ld(&bar[XB_XGEN(b.x)]) == gen, bar);
            __builtin_amdgcn_fence(__ATOMIC_ACQUIRE, "agent");
            asm volatile("s_waitcnt vmcnt(0)" ::: "memory");
        }
    }
    __syncthreads();
}

namespace pg8 {
constexpr int BM = 256, BK = 64, HALF = 128, HTB = HALF * BK * 2, STAGE_BYTES = 8 * HTB;
__host__ __device__ __forceinline__ int lds_byte(int r, int c) { const int st = (r >> 4) * 2 + (c >> 5), rr = r & 15, cc = c & 31, ob = rr * 64 + cc * 2; return st * 1024 + (ob ^ (((ob >> 9) & 1) << 5)); }
__host__ __device__ __forceinline__ void stage_rc(int b, int& R, int& C) { const int st = b / 1024, sb = b % 1024, swz = sb ^ (((sb >> 9) & 1) << 5); R = (st >> 1) * 16 + swz / 64; C = (st & 1) * 32 + (swz % 64) / 2; }
__host__ __device__ __forceinline__ int permrow(int R) { const int wc = R >> 5, n = (R >> 4) & 1, i = R & 15; return 64 * (wc >> 1) + 16 * (wc & 1) + i + 32 * n; }
__host__ __device__ __forceinline__ int row16(int R, int bj) { return 64 * (R >> 5) + 16 * ((R >> 2) & 3) + 8 * bj + 4 * ((R >> 4) & 1) + (R & 3); }
struct Unit { const char* A; const char* B; int nt, pm, pn, kind, bperm; };

template <class Epi, class Sched>
__device__ __forceinline__ void gemm_phase(LAS unsigned char* lds, const int lda, const int ldb, const Sched& S, const Epi& E, const int tid) {
    const int wid = __builtin_amdgcn_readfirstlane(tid >> 6), lane = tid & 63, wr = wid >> 2, wc = wid & 3, fr = lane & 15, fq = lane >> 4;
    unsigned voffA[2];
#pragma unroll
    for (int i = 0; i < 2; ++i) { int R, C; stage_rc(tid * 16 + i * 8192, R, C); voffA[i] = (unsigned)(R * lda + C) * 2u; }
    unsigned vBc0[2], vBc1[2];
#define PG8_VB(u, v0, v1) do { _Pragma("unroll") for (int _i = 0; _i < 2; ++_i) { int R_, C_; stage_rc(tid * 16 + _i * 8192, R_, C_); \
        const int r0_ = (u).bperm ? row16(R_, 0) : permrow(R_), r1_ = (u).bperm ? row16(R_, 1) : 128 + permrow(R_); \
        v0[_i] = (unsigned)(r0_ * ldb + C_) * 2u; v1[_i] = (unsigned)(r1_ * ldb + C_) * 2u; } } while (0)
    const size_t kstep = (size_t)(BK * 2);
    const size_t hstepA = (size_t)HALF * lda * 2;
    const unsigned ldsw = (unsigned)wid * 1024u;
    const int aoff = lds_byte(wr * 64 + fr, fq * 8), boff = lds_byte(wc * 32 + fr, fq * 8);
#define PG8_SA(b, h) (((b) * 2 + (h)) * HTB)
#define PG8_SB(b, h) ((4 + (b) * 2 + (h)) * HTB)
#define PG8_STAGE(bufoff, gbase, voff) do { _Pragma("unroll") for (int _i = 0; _i < 2; ++_i) \
        __builtin_amdgcn_global_load_lds((const unsigned*)((const char*)(gbase) + (voff)[_i]), (LAS unsigned*)(lds + (bufoff) + ldsw + _i * 8192), 16, 0, 0); } while (0)
#define PG8_LDA(dst, b, h) do { _Pragma("unroll") for (int m = 0; m < 4; ++m) _Pragma("unroll") for (int k = 0; k < 2; ++k) dst[m][k] = *(const LAS f16x8*)(lds + PG8_SA(b, h) + aoff + m * 2048 + k * 1024); } while (0)
#define PG8_LDB(dst, b, h) do { _Pragma("unroll") for (int n = 0; n < 2; ++n) _Pragma("unroll") for (int k = 0; k < 2; ++k) dst[n][k] = *(const LAS f16x8*)(lds + PG8_SB(b, h) + boff + n * 2048 + k * 1024); } while (0)
#define PG8_MMA(ai, bj, At, Bt) do { __builtin_amdgcn_s_setprio(1); _Pragma("unroll") for (int m = 0; m < 4; ++m) _Pragma("unroll") for (int n = 0; n < 2; ++n) _Pragma("unroll") for (int k = 0; k < 2; ++k) \
        acc[ai][bj][m][n] = __builtin_amdgcn_mfma_f32_16x16x32_f16(Bt[n][k], At[m][k], acc[ai][bj][m][n], 0, 0, 0); __builtin_amdgcn_s_setprio(0); } while (0)
#define PG8_WAIT_V(n) asm volatile("s_waitcnt vmcnt(" #n ")" ::: "memory")
#define PG8_WAIT_L(n) asm volatile("s_waitcnt lgkmcnt(" #n ")" ::: "memory")
#define PG8_BAR __builtin_amdgcn_s_barrier()
#define PG8_SCHED __builtin_amdgcn_sched_barrier(0)
    Unit cur, nxt; int ui = 0;
    if (!S.next(0, cur)) return;
    f32x4 acc[2][2][4][2];
#pragma unroll
    for (int a = 0; a < 2; ++a)
#pragma unroll
        for (int b = 0; b < 2; ++b)
#pragma unroll
            for (int m = 0; m < 4; ++m)
#pragma unroll
                for (int n = 0; n < 2; ++n) acc[a][b][m][n] = (f32x4){0.f, 0.f, 0.f, 0.f};
    f16x8 At[4][2], B0[2][2], B1[2][2];
    const char* cA = cur.A; const char* cB = cur.B;
    PG8_VB(cur, vBc0, vBc1);
    PG8_STAGE(PG8_SB(0, 0), cB, vBc0); PG8_STAGE(PG8_SB(0, 1), cB, vBc1); PG8_STAGE(PG8_SA(0, 0), cA, voffA); PG8_STAGE(PG8_SA(0, 1), cA + hstepA, voffA);
    if (wr == 1) PG8_BAR;
    PG8_WAIT_V(2); PG8_BAR;
    PG8_STAGE(PG8_SB(1, 0), cB + kstep, vBc0); PG8_STAGE(PG8_SA(1, 0), cA + kstep, voffA); PG8_STAGE(PG8_SB(1, 1), cB + kstep, vBc1);
    PG8_WAIT_V(6); PG8_BAR;
    for (;;) {
        const bool has_next = S.next(ui + 1, nxt);
        const char* nA = has_next ? nxt.A : cA; const char* nB = has_next ? nxt.B : cB;
        const int nt = cur.nt;
        for (int t = 0; t < nt; t += 2) {
            const bool last = (t == nt - 2);
            unsigned vb0[2], vb1[2]; vb0[0] = vBc0[0]; vb0[1] = vBc0[1]; vb1[0] = vBc1[0]; vb1[1] = vBc1[1];
            if (last && has_next) PG8_VB(nxt, vb0, vb1);
            const char* a1 = cA + (size_t)(t + 1) * kstep;
            const char* a2 = last ? nA : cA + (size_t)(t + 2) * kstep; const char* b2 = last ? nB : cB + (size_t)(t + 2) * kstep;
            const char* a3 = a2 + kstep; const char* b3 = b2 + kstep;
            PG8_LDB(B0, 0, 0); PG8_LDB(B1, 0, 1); PG8_SCHED; PG8_LDA(At, 0, 0); PG8_STAGE(PG8_SA(1, 1), a1 + hstepA, voffA);
            PG8_WAIT_V(8); PG8_WAIT_L(0); PG8_BAR; PG8_MMA(0, 0, At, B0); PG8_MMA(0, 1, At, B1); PG8_BAR; PG8_SCHED;
            PG8_LDA(At, 0, 1); PG8_STAGE(PG8_SB(0, 0), b2, vb0); PG8_STAGE(PG8_SB(0, 1), b2, vb1); PG8_STAGE(PG8_SA(0, 0), a2, voffA);
            PG8_WAIT_V(8); PG8_WAIT_L(0); PG8_BAR; PG8_MMA(1, 0, At, B0); PG8_MMA(1, 1, At, B1); PG8_BAR; PG8_SCHED;
            PG8_LDB(B0, 1, 0); PG8_LDB(B1, 1, 1); PG8_SCHED; PG8_LDA(At, 1, 0); PG8_STAGE(PG8_SA(0, 1), a2 + hstepA, voffA);
            PG8_WAIT_V(8); PG8_WAIT_L(0); PG8_BAR; PG8_MMA(0, 0, At, B0); PG8_MMA(0, 1, At, B1); PG8_BAR; PG8_SCHED;
            PG8_LDA(At, 1, 1); PG8_STAGE(PG8_SB(1, 0), b3, vb0); PG8_STAGE(PG8_SB(1, 1), b3, vb1); PG8_STAGE(PG8_SA(1, 0), a3, voffA);
            PG8_WAIT_V(8); PG8_WAIT_L(0); PG8_BAR; PG8_MMA(1, 0, At, B0); PG8_MMA(1, 1, At, B1); PG8_BAR; PG8_SCHED;
        }
        if (wr == 0) PG8_BAR;
        E(acc, cur, wr, wc, fr, fq);
        if (!has_next) break;
#pragma unroll
        for (int a = 0; a < 2; ++a)
#pragma unroll
            for (int b = 0; b < 2; ++b)
#pragma unroll
                for (int m = 0; m < 4; ++m)
#pragma unroll
                    for (int n = 0; n < 2; ++n) acc[a][b][m][n] = (f32x4){0.f, 0.f, 0.f, 0.f};
        cur = nxt; cA = nA; cB = nB; ++ui; PG8_VB(cur, vBc0, vBc1);
        if (wr == 1) PG8_BAR;
    }
    PG8_WAIT_V(0);
    PG8_BAR;
#undef PG8_SA
#undef PG8_SB
#undef PG8_STAGE
#undef PG8_LDA
#undef PG8_LDB
#undef PG8_MMA
#undef PG8_WAIT_V
#undef PG8_WAIT_L
#undef PG8_BAR
#undef PG8_SCHED
#undef PG8_VB
}
template <class F>
__device__ __forceinline__ void epi_iter(const f32x4 (&acc)[2][2][4][2], const Unit& u, int wr, int wc, int fr, int fq, const F& f) {
#pragma unroll
    for (int ai = 0; ai < 2; ++ai)
#pragma unroll
        for (int m = 0; m < 4; ++m) {
            const int row = u.pm * BM + ai * HALF + wr * 64 + m * 16 + fr;
#pragma unroll
            for (int bj = 0; bj < 2; ++bj) {
                const int col = u.pn * BM + bj * HALF + (wc >> 1) * 64 + (wc & 1) * 16 + 4 * fq;
                f(row, col, acc[ai][bj][m][0], acc[ai][bj][m][1], u.kind);
            }
        }
}
template <class F>
__device__ __forceinline__ void epi_iter16(const f32x4 (&acc)[2][2][4][2], const Unit& u, int wr, int wc, int fr, int fq, const F& f) {
#pragma unroll
    for (int ai = 0; ai < 2; ++ai)
#pragma unroll
        for (int m = 0; m < 4; ++m) {
            const int row = u.pm * BM + ai * HALF + wr * 64 + m * 16 + fr, col = u.pn * BM + 64 * wc + 16 * fq;
            f.op16(row, col, acc[ai][0][m][0], acc[ai][0][m][1], acc[ai][1][m][0], acc[ai][1][m][1], u.kind);
        }
}
}

struct Args { const float* in[28]; float* out; unsigned char* ws; int ph_lo, ph_hi, li, pad; };
struct Frame {
    LAS unsigned char* lds;
    int tid, lane, wave, G, bid, gw, NGW;
    const float* const* in; float* out; unsigned char* ws;
    unsigned long long pacc2;
};
#define WSP(T, off) ((T*)(F.ws + (off)))
__device__ __forceinline__ int fresh_lane() {
    int l; asm volatile("v_mbcnt_lo_u32_b32 %0, -1, 0\n\tv_mbcnt_hi_u32_b32 %0, -1, %0" : "=v"(l));
    __builtin_assume(l >= 0 && l < 64);
    return l;
}
__device__ __forceinline__ void fresh_tid(Frame& F) { const int l = fresh_lane(); F.lane = l; F.tid = F.wave * 64 + l; }

template <class Fn>
__device__ __forceinline__ void small_tile(const f16* __restrict__ A, int lda, const f16* __restrict__ Bt, int ldb, int K, int row0, int col0, int kind, const Fn& f, int lane) {
    f32x16 acc0, acc1;
#pragma unroll
    for (int i = 0; i < 16; ++i) { acc0[i] = 0.f; acc1[i] = 0.f; }
    const f16* ap = A + (size_t)(row0 + (lane & 31)) * lda + 8 * (lane >> 5);
    const f16* b0 = Bt + (size_t)(col0 + (lane & 31)) * ldb + 8 * (lane >> 5);
    const f16* b1 = b0 + (size_t)32 * ldb;
#pragma unroll 4
    for (int k = 0; k < K; k += 16) {
        const f16x8 a = *(const f16x8*)(ap + k), x0 = *(const f16x8*)(b0 + k), x1 = *(const f16x8*)(b1 + k);
        acc0 = __builtin_amdgcn_mfma_f32_32x32x16_f16(x0, a, acc0, 0, 0, 0);
        acc1 = __builtin_amdgcn_mfma_f32_32x32x16_f16(x1, a, acc1, 0, 0, 0);
    }
    const int row = row0 + (lane & 31), cb = col0 + 4 * (lane >> 5);
#pragma unroll
    for (int g = 0; g < 4; ++g)
        f(row, cb + 8 * g, (f32x4){acc0[4 * g], acc0[4 * g + 1], acc0[4 * g + 2], acc0[4 * g + 3]}, (f32x4){acc1[4 * g], acc1[4 * g + 1], acc1[4 * g + 2], acc1[4 * g + 3]}, kind);
}

__device__ __forceinline__ f32x4 sig4(f32x4 v);
struct EpiG1 {
    f16* ZR; f16* YRA; f16* KB; f16* VB; const f32x2* rope; float* out; int l; f16* gateR; f16* gateA;
    __device__ __forceinline__ void operator()(int row, int col, f32x4 v0, f32x4 v1, int) const {
        if (col < OQ) {
            f16* p = ZR + (size_t)row * SHW + col;
            *(f16x4*)p = cvt4(v0); *(f16x4*)(p + 32) = cvt4(v1);
            const bool lastp = row < MP ? ((row & (SEQ - 1)) == SEQ - 1) : (((row - MP) & 3) == 3);
            if (lastp) {
                float* o = row < MP ? out + O_PSH + ((size_t)l * NB + (row >> 13)) * SHW + col : out + O_SSH + ((size_t)l * DECB + ((row - MP) >> 2)) * SHW + col;
                *(f32x4*)o = v0; *(f32x4*)(o + 32) = v1;
            }
        } else if (col < OV) {
            const int pos = row < MP ? (row & (SEQ - 1)) : PAST + ((row - MP) & 3);
            const int d = (col - OQ) & 63;
            const f32x4* rp = (const f32x4*)(rope + (size_t)pos * 32 + d);
            const f32x4 c01 = rp[0], c23 = rp[1];
            const f32x4 c = (f32x4){c01.x, c01.z, c23.x, c23.z}, s = (f32x4){c01.y, c01.w, c23.y, c23.w};
            f32x4 o1 = v0 * c - v1 * s, o2 = v1 * c + v0 * s;
            if (col < OK_) {
                f16* p = YRA + (size_t)row * 1024 + 512 + (col - OQ);
                *(f16x4*)p = cvt4(o1 * 0.125f); *(f16x4*)(p + 32) = cvt4(o2 * 0.125f);
            } else {
                const int kc = col - OK_;
                f16* p = KB + (size_t)row * 128 + kc;
                *(f16x4*)p = cvt4(o1); *(f16x4*)(p + 32) = cvt4(o2);
                if (row < MP) { const int t = row & (SEQ - 1); if (t >= SEQ - WBUF) { float* o = out + O_PK + (((size_t)l * NB + (row >> 13)) * WBUF + (t - (SEQ - WBUF))) * 128 + kc; *(f32x4*)o = o1; *(f32x4*)(o + 32) = o2; } }
                else { float* o = out + O_SK + (((size_t)l * DECB + ((row - MP) >> 2)) * WBUF + (WBUF - DECT + ((row - MP) & 3))) * 128 + kc; *(f32x4*)o = o1; *(f32x4*)(o + 32) = o2; }
            }
        } else if (col >= OGR) {
            f16* p = (col < OGA ? gateR + (col - OGR) : gateA + (col - OGA)) + (size_t)(row - MP) * D;
            *(f16x4*)p = cvt4(sig4(v0)); *(f16x4*)(p + 32) = cvt4(sig4(v1));
        } else {
            const int vc = col - OV;
            f16* p = VB + (size_t)row * 128 + vc;
            *(f16x4*)p = cvt4(v0); *(f16x4*)(p + 32) = cvt4(v1);
            if (row < MP) { const int t = row & (SEQ - 1); if (t >= SEQ - WBUF) { float* o = out + O_PV + (((size_t)l * NB + (row >> 13)) * WBUF + (t - (SEQ - WBUF))) * 128 + vc; *(f32x4*)o = v0; *(f32x4*)(o + 32) = v1; } }
            else { float* o = out + O_SV + (((size_t)l * DECB + ((row - MP) >> 2)) * WBUF + (WBUF - DECT + ((row - MP) & 3))) * 128 + vc; *(f32x4*)o = v0; *(f32x4*)(o + 32) = v1; }
        }
    }
    __device__ __forceinline__ void op16(int row, int col, f32x4 v0, f32x4 v1, f32x4 v2, f32x4 v3, int) const {
        if (col < OQ) {
            f16* p = ZR + (size_t)row * SHW + col;
            *(f16x8*)p = cvt8(v0, v1); *(f16x8*)(p + 8) = cvt8(v2, v3);
            const bool lastp = row < MP ? ((row & (SEQ - 1)) == SEQ - 1) : (((row - MP) & 3) == 3);
            if (lastp) {
                float* o = row < MP ? out + O_PSH + ((size_t)l * NB + (row >> 13)) * SHW + col : out + O_SSH + ((size_t)l * DECB + ((row - MP) >> 2)) * SHW + col;
                *(f32x4*)o = v0; *(f32x4*)(o + 4) = v1; *(f32x4*)(o + 8) = v2; *(f32x4*)(o + 12) = v3;
            }
        } else {
            f16* p = (col < OGA ? gateR + (col - OGR) : gateA + (col - OGA)) + (size_t)(row - MP) * D;
            *(f16x8*)p = cvt8(sig4(v0), sig4(v1)); *(f16x8*)(p + 8) = cvt8(sig4(v2), sig4(v3));
        }
    }
};
__device__ __forceinline__ f32x4 sig4(f32x4 v) { return (f32x4){sigmoidf_(v.x), sigmoidf_(v.y), sigmoidf_(v.z), sigmoidf_(v.w)}; }
constexpr int GHP = 23;
struct EpiMix {
    f16* MIX; f16* TMP; const f16* gateR; const f16* gateA; const f16* GH;
    __device__ __forceinline__ void operator()(int row, int col, f32x4 v0, f32x4 v1, int kind) const {
        f16* p = MIX + (size_t)row * D + col; f16* q = TMP + (size_t)row * D + col;
        if (kind >= 4) {
            const f16* gp = (kind == 4 ? gateR : gateA) + (size_t)(row - MP) * D + col;
            const f32x4 g0 = up4(*(const f16x4*)gp), g1 = up4(*(const f16x4*)(gp + 32));
            f32x4 m0 = (f32x4){0.f, 0.f, 0.f, 0.f}, m1 = m0;
            if (kind == 5) { m0 = up4(*(f16x4*)p); m1 = up4(*(f16x4*)(p + 32)); }
            *(f16x4*)p = cvt4(m0 + g0 * v0); *(f16x4*)(p + 32) = cvt4(m1 + g1 * v1);
            return;
        }
        if (kind == 0) { *(f16x4*)p = cvt4(sig4(v0)); *(f16x4*)(p + 32) = cvt4(sig4(v1)); }
        else if (kind == 1) { const f32x4 m0 = up4(*(f16x4*)p), m1 = up4(*(f16x4*)(p + 32)); *(f16x4*)p = cvt4(m0 * v0); *(f16x4*)(p + 32) = cvt4(m1 * v1); }
        else if (kind == 2) { *(f16x4*)q = cvt4(sig4(v0)); *(f16x4*)(q + 32) = cvt4(sig4(v1)); }
        else { const f32x4 m0 = up4(*(f16x4*)p), m1 = up4(*(f16x4*)(p + 32)), t0 = up4(*(f16x4*)q), t1 = up4(*(f16x4*)(q + 32));
               *(f16x4*)p = cvt4(m0 + t0 * v0); *(f16x4*)(p + 32) = cvt4(m1 + t1 * v1); }
    }
    __device__ __forceinline__ void op16(int row, int col, f32x4 v0, f32x4 v1, f32x4 v2, f32x4 v3, int kind) const {
        f16* p = MIX + (size_t)row * D + col; f16* q = TMP + (size_t)row * D + col;
        if (kind >= 4) {
            const f16* gp = (kind == 4 ? gateR : gateA) + (size_t)(row - MP) * D + col;
            const f16x8 ga = *(const f16x8*)gp, gb = *(const f16x8*)(gp + 8);
            f32x4 m0 = (f32x4){0.f, 0.f, 0.f, 0.f}, m1 = m0, m2 = m0, m3 = m0;
            if (kind == 5) { const f16x8 ma = *(const f16x8*)p, mb = *(const f16x8*)(p + 8); m0 = up8lo(ma); m1 = up8hi(ma); m2 = up8lo(mb); m3 = up8hi(mb); }
            *(f16x8*)p = cvt8(m0 + up8lo(ga) * v0, m1 + up8hi(ga) * v1); *(f16x8*)(p + 8) = cvt8(m2 + up8lo(gb) * v2, m3 + up8hi(gb) * v3);
            return;
        }
        if (kind == 0) { *(f16x8*)p = cvt8(sig4(v0), sig4(v1)); *(f16x8*)(p + 8) = cvt8(sig4(v2), sig4(v3)); }
        else if (kind == 1) { const f16* gp = (row < GHP * 256 ? GH : (const f16*)MIX) + (size_t)row * D + col; const f16x8 ma = *(const f16x8*)gp, mb = *(const f16x8*)(gp + 8);
            *(f16x8*)p = cvt8(up8lo(ma) * v0, up8hi(ma) * v1); *(f16x8*)(p + 8) = cvt8(up8lo(mb) * v2, up8hi(mb) * v3); }
        else if (kind == 2) { *(f16x8*)q = cvt8(sig4(v0), sig4(v1)); *(f16x8*)(q + 8) = cvt8(sig4(v2), sig4(v3)); }
        else { const f16x8 ma = *(const f16x8*)p, mb = *(const f16x8*)(p + 8), ta = *(const f16x8*)q, tb = *(const f16x8*)(q + 8);
            *(f16x8*)p = cvt8(up8lo(ma) + up8lo(ta) * v0, up8hi(ma) + up8hi(ta) * v1); *(f16x8*)(p + 8) = cvt8(up8lo(mb) + up8lo(tb) * v2, up8hi(mb) + up8hi(tb) * v3); }
    }
};
struct EpiRes {
    f16* XH; float* SLAB;
    __device__ __forceinline__ void operator()(int row, int col, f32x4 v0, f32x4 v1, int kind) const {
        if (kind > 0) { f16* sp = (f16*)SLAB + ((size_t)(kind - 1) * MS + (row - MP)) * D + col; *(f16x4*)sp = cvt4(v0); *(f16x4*)(sp + 32) = cvt4(v1); return; }
        f16* p = XH + (size_t)row * D + col;
        const f32x4 x0 = up4(*(f16x4*)p), x1 = up4(*(f16x4*)(p + 32));
        *(f16x4*)p = cvt4(x0 * ALPHA + v0); *(f16x4*)(p + 32) = cvt4(x1 * ALPHA + v1);
    }
    __device__ __forceinline__ void op16(int row, int col, f32x4 v0, f32x4 v1, f32x4 v2, f32x4 v3, int kind) const {
        if (kind > 0) { f16* sp = (f16*)SLAB + ((size_t)(kind - 1) * MS + (row - MP)) * D + col; *(f16x8*)sp = cvt8(v0, v1); *(f16x8*)(sp + 8) = cvt8(v2, v3); return; }
        f16* p = XH + (size_t)row * D + col;
        const f16x8 xa = *(const f16x8*)p, xb = *(const f16x8*)(p + 8);
        *(f16x8*)p = cvt8(up8lo(xa) * ALPHA + v0, up8hi(xa) * ALPHA + v1); *(f16x8*)(p + 8) = cvt8(up8lo(xb) * ALPHA + v2, up8hi(xb) * ALPHA + v3);
    }
};
struct EpiUp {
    f16* H;
    __device__ __forceinline__ void operator()(int row, int col, f32x4 v0, f32x4 v1, int) const {
        f16* p = H + (size_t)row * FF + col;
        f32x4 a = __builtin_elementwise_max(v0, (f32x4){0.f, 0.f, 0.f, 0.f}), b = __builtin_elementwise_max(v1, (f32x4){0.f, 0.f, 0.f, 0.f});
        *(f16x4*)p = cvt4(a * a); *(f16x4*)(p + 32) = cvt4(b * b);
    }
    __device__ __forceinline__ void op16(int row, int col, f32x4 v0, f32x4 v1, f32x4 v2, f32x4 v3, int) const {
        f16* p = H + (size_t)row * FF + col; const f32x4 z = (f32x4){0.f, 0.f, 0.f, 0.f};
        const f32x4 a = __builtin_elementwise_max(v0, z), b = __builtin_elementwise_max(v1, z), c = __builtin_elementwise_max(v2, z), d = __builtin_elementwise_max(v3, z);
        *(f16x8*)p = cvt8(a * a, b * b); *(f16x8*)(p + 8) = cvt8(c * c, d * d);
    }
};
template <class Fn> struct EpiBig16 {
    Fn f;
    __device__ __forceinline__ void operator()(const f32x4 (&acc)[2][2][4][2], const pg8::Unit& u, int wr, int wc, int fr, int fq) const {
        asm volatile("" : "+v"(fr), "+v"(fq));
        pg8::epi_iter16(acc, u, wr, wc, fr, fq, f); }
};
template <class Fn> struct EpiBigR {
    Fn f;
    __device__ __forceinline__ void operator()(const f32x4 (&acc)[2][2][4][2], const pg8::Unit& u, int wr, int wc, int fr, int fq) const {
        asm volatile("" : "+v"(fr), "+v"(fq));
        pg8::epi_iter(acc, u, wr, wc, fr, fq, f); }
};
template <class Fn> struct EpiBig {
    Fn f;
    __device__ __forceinline__ void operator()(const f32x4 (&acc)[2][2][4][2], const pg8::Unit& u, int wr, int wc, int fr, int fq) const {
        asm volatile("" : "+v"(fr), "+v"(fq));
        if (u.bperm) pg8::epi_iter16(acc, u, wr, wc, fr, fq, f); else pg8::epi_iter(acc, u, wr, wc, fr, fq, f); }
};

__device__ __forceinline__ bool tile_of(int L, int nM, int nN, int& pm, int& pn) {
    const int nwg = nM * nN; if (L >= nwg) return false;
    int wgid = L; { const int q = nwg / 8, r = nwg % 8, xcd = wgid % 8, off = wgid / 8; wgid = (xcd < r ? xcd * (q + 1) : r * (q + 1) + (xcd - r) * q) + off; }
    const int WGM = 8, nig = WGM * nN, gid = wgid / nig, fm = gid * WGM, gsz = (nM - fm) < WGM ? (nM - fm) : WGM;
    pm = fm + ((wgid % nig) % gsz); pn = (wgid % nig) / gsz; return true;
}
struct SchedPlain {
    const f16* A; const f16* B; int lda, ldb, nM, nN, nt, G, c;
    __device__ __forceinline__ bool next(int i, pg8::Unit& u) const {
        int pm, pn; if (!tile_of(i * G + c, nM, nN, pm, pn)) return false;
        u.A = (const char*)(A + (size_t)pm * 256 * lda); u.B = (const char*)(B + (size_t)pn * 256 * ldb); u.nt = nt; u.pm = pm; u.pn = pn; u.kind = 0; u.bperm = 1; return true;
    }
};
struct SchedG1 {
    const f16* XH; const f16* WIN; int G, c;
    __device__ __forceinline__ bool next(int i, pg8::Unit& u) const {
        const int L = i * G + c; int pm, pn;
        if (L < 660) tile_of(L, 66, 10, pm, pn);
        else if (L < 676) { pm = 64 + ((L - 660) >> 3); pn = 10 + ((L - 660) & 7); }
        else return false;
        u.A = (const char*)(XH + (size_t)pm * 256 * D); u.B = (const char*)(WIN + (size_t)pn * 256 * D); u.nt = 16; u.pm = pm; u.pn = pn; u.kind = 0; u.bperm = 0; return true;
    }
};
struct SchedG1Z {
    const f16* XH; const f16* WIN; int G, c;
    __device__ __forceinline__ bool next(int i, pg8::Unit& u) const {
        const int L = i * G + c; int pm, pn;
        if (L < 462) tile_of(L, 66, 7, pm, pn);
        else if (L < 478) { pm = 64 + ((L - 462) >> 3); pn = 10 + ((L - 462) & 7); }
        else return false;
        u.A = (const char*)(XH + (size_t)pm * 256 * D); u.B = (const char*)(WIN + (size_t)pn * 256 * D); u.nt = 16; u.pm = pm; u.pn = pn; u.kind = 0; u.bperm = 1; return true;
    }
};
struct SchedG1R {
    const f16* XH; const f16* WIN; int G, c;
    __device__ __forceinline__ bool next(int i, pg8::Unit& u) const {
        int pm, pn; if (!tile_of(i * G + c, 66, 3, pm, pn)) return false; pn += 7;
        u.A = (const char*)(XH + (size_t)pm * 256 * D); u.B = (const char*)(WIN + (size_t)pn * 256 * D); u.nt = 16; u.pm = pm; u.pn = pn; u.kind = 0; u.bperm = 0; return true;
    }
};
struct SchedMix {
    const f16* XH; const f16* YRA; const f16* WIN; const f16* WBR; int G, c, np0, with_sample, pre_gate;
    __device__ __forceinline__ bool next(int i, pg8::Unit& u) const {
        const int np = np0 == 0 ? 0 : (c < 256 ? (256 - c + G - 1) / G : 0), ns = pre_gate ? 3 : 4;
        if (i >= ns * np && !with_sample) return false;
        int pm, pn, k;
        if (i < ns * np) { tile_of((i / ns) * G + c, MP / 256, 4, pm, pn); k = i % ns + (pre_gate ? 1 : 0); }
        else { const int j = i - ns * np, t = c + (j >> 1) * G; if (t >= 8) return false; pm = 64 + (t >> 2); pn = t & 3; k = 4 + (j & 1); }
        u.pm = pm; u.pn = pn; u.kind = k; u.bperm = 1;
        if (k == 0) { u.A = (const char*)(XH + (size_t)pm * 256 * D); u.B = (const char*)(WIN + (size_t)(OGR + pn * 256) * D); u.nt = 16; }
        else if (k == 2) { u.A = (const char*)(XH + (size_t)pm * 256 * D); u.B = (const char*)(WIN + (size_t)(OGA + pn * 256) * D); u.nt = 16; }
        else if (k == 1 || k == 4) { u.A = (const char*)(YRA + (size_t)pm * 256 * D); u.B = (const char*)(WBR + (size_t)pn * 256 * D); u.nt = 8; }
        else { u.A = (const char*)(YRA + (size_t)pm * 256 * D + 512); u.B = (const char*)(WBR + (size_t)pn * 256 * D + 512); u.nt = 8; }
        return true;
    }
};
struct SchedGate {
    const f16* XH; const f16* WIN; int j, p0;
    __device__ __forceinline__ bool next(int i, pg8::Unit& u) const {
        if (i > 0 || j < 0) return false;
        const int pm = p0 + (j >> 2), pn = j & 3;
        u.pm = pm; u.pn = pn; u.kind = 0; u.bperm = 1; u.A = (const char*)(XH + (size_t)pm * 256 * D); u.B = (const char*)(WIN + (size_t)(OGR + pn * 256) * D); u.nt = 16; return true;
    }
};
struct SchedSplit {
    const f16* A; const f16* B; int ld, K, SPL, G, c;
    __device__ __forceinline__ bool next(int i, pg8::Unit& u) const {
        const int np = c < 256 ? (256 - c + G - 1) / G : 0;
        if (i < np) { int pm, pn; tile_of(i * G + c, MP / 256, 4, pm, pn); u.A = (const char*)(A + (size_t)pm * 256 * ld); u.B = (const char*)(B + (size_t)pn * 256 * ld); u.nt = K / 64; u.pm = pm; u.pn = pn; u.kind = 0; u.bperm = 1; return true; }
        const int uu = c + (i - np) * G; if (uu >= 8 * SPL) return false;
        const int t = uu / SPL, s = uu % SPL, ks = K / SPL;
        u.pm = 64 + (t >> 2); u.pn = t & 3; u.kind = 1 + s; u.nt = ks / 64; u.bperm = 1;
        u.A = (const char*)(A + (size_t)u.pm * 256 * ld + (size_t)s * ks); u.B = (const char*)(B + (size_t)u.pn * 256 * ld + (size_t)s * ks); return true;
    }
};

__device__ __forceinline__ void transpose_item(const float* __restrict__ W, int K, int N, f16* __restrict__ dst, int ldd, int koff, LAS float* scr, int item, int lane) {
    const int nblk = N / 32, kb = item / nblk, nb = item % nblk, k0 = 64 * kb, n0 = 32 * nb;
    const int lr = lane >> 3, lc = 4 * (lane & 7);
    f32x4 v[8];
#pragma unroll
    for (int i = 0; i < 8; ++i) v[i] = *(const f32x4*)(W + (size_t)(k0 + 8 * i + lr) * N + n0 + lc);
#pragma unroll
    for (int i = 0; i < 8; ++i) *(LAS f32x4*)(scr + (8 * i + lr) * 36 + ((lc + 4 * i) & 31)) = v[i];
    LDS_WAIT(); asm volatile("" ::: "memory");
    const int c = lane & 7;
#pragma unroll
    for (int j = 0; j < 4; ++j) { const int n = (lane >> 3) + 8 * j; const LAS float* s = scr + (8 * c) * 36 + ((n + 4 * c) & 31);
        f16x8 o; o[0] = (f16)s[0 * 36]; o[1] = (f16)s[1 * 36]; o[2] = (f16)s[2 * 36]; o[3] = (f16)s[3 * 36]; o[4] = (f16)s[4 * 36]; o[5] = (f16)s[5 * 36]; o[6] = (f16)s[6 * 36]; o[7] = (f16)s[7 * 36];
        *(f16x8*)(dst + (size_t)(n0 + n) * ldd + koff + k0 + 8 * c) = o; }
    LDS_WAIT(); asm volatile("" ::: "memory");
}
__device__ __forceinline__ void convert_layer_weights(Frame& F, int l, int part, int gw, int ngw) {
    LAS float* scr = (LAS float*)(F.lds + F.wave * 16384);
    constexpr int I_IN = (D / 64) * (INW / 32), I_BR = (RW / 64) * (D / 32), I_OUT = (D / 64) * (D / 32), I_UP = (D / 64) * (FF / 32), I_DN = (FF / 64) * (D / 32);
    constexpr int NIT = I_IN + 2 * I_BR + I_OUT + I_UP + I_DN;
    const int lo = part == 1 ? I_IN : 0, hi = part == 0 ? I_IN : NIT;
    for (int it = lo + gw; it < hi; it += ngw) {
        int r = it;
        if (r < I_IN) { transpose_item(F.in[6] + (size_t)l * D * INW, D, INW, WSP(f16, WS_WIN), D, 0, scr, r, F.lane); continue; } r -= I_IN;
        if (r < I_BR) { transpose_item(F.in[19] + (size_t)l * RW * D, RW, D, WSP(f16, WS_WBR), D, 0, scr, r, F.lane); continue; } r -= I_BR;
        if (r < I_BR) { transpose_item(F.in[20] + (size_t)l * RW * D, RW, D, WSP(f16, WS_WBR), D, 512, scr, r, F.lane); continue; } r -= I_BR;
        if (r < I_OUT) { transpose_item(F.in[21] + (size_t)l * D * D, D, D, WSP(f16, WS_WOUT), D, 0, scr, r, F.lane); continue; } r -= I_OUT;
        if (r < I_UP) { transpose_item(F.in[24] + (size_t)l * D * FF, D, FF, WSP(f16, WS_WUP), D, 0, scr, r, F.lane); continue; } r -= I_UP;
        transpose_item(F.in[25] + (size_t)l * FF * D, FF, D, WSP(f16, WS_WDN), FF, 0, scr, r, F.lane);
    }
}
__device__ __forceinline__ void prologue(Frame& F, const double* invf) {
    convert_layer_weights(F, 0, F.G == 256 ? 0 : 2, F.gw, F.NGW);
    LAS float* scr = (LAS float*)(F.lds + F.wave * 16384);
    constexpr int I_D = (64 / 64) * (RW / 32), I_G = (128 / 64) * (RW / 32), NL = 2 * I_D + I_G;
    for (int it = F.gw; it < DEPTH * NL; it += F.NGW) {
        const int l = it / NL; int r = it % NL; f16* base = (f16*)(F.ws + WS_LORA + (size_t)l * LORA_STRIDE);
        if (r < I_D) { transpose_item(F.in[9] + (size_t)l * 64 * RW, 64, RW, base, 64, 0, scr, r, F.lane); continue; } r -= I_D;
        if (r < I_D) { transpose_item(F.in[11] + (size_t)l * 64 * RW, 64, RW, base + 512 * 64, 64, 0, scr, r, F.lane); continue; } r -= I_D;
        transpose_item(F.in[12] + (size_t)l * 128 * RW, 128, RW, base + 2 * 512 * 64, 128, 0, scr, r, F.lane);
    }
    const size_t gt = (size_t)F.bid * NTHR + F.tid, NT = (size_t)F.G * NTHR;
    for (size_t i = gt; i < (size_t)M * D / 8; i += NT) {
        const size_t e = i * 8; const float* src = e < (size_t)MP * D ? F.in[0] + e : F.in[1] + (e - (size_t)MP * D);
        const f32x4 a = *(const f32x4*)src, b = *(const f32x4*)(src + 4);
        f16x8 o; o[0] = (f16)a.x; o[1] = (f16)a.y; o[2] = (f16)a.z; o[3] = (f16)a.w; o[4] = (f16)b.x; o[5] = (f16)b.y; o[6] = (f16)b.z; o[7] = (f16)b.w;
        *(f16x8*)(WSP(f16, WS_XH) + e) = o;
    }
    f32x2* rope = WSP(f32x2, WS_ROPE);
    for (size_t i = gt; i < (size_t)(PAST + DECT) * 32; i += NT) {
        const int pos = (int)(i >> 5), d = (int)(i & 31);
        const double ang = (double)pos * invf[d];
        const double n = __builtin_rint(ang * 0.63661977236758134308);
        double r = __builtin_fma(-n, 1.57079632679489655800e+00, ang); r = __builtin_fma(-n, 6.12323399573676603587e-17, r);
        const double r2 = r * r;
        double s = -2.50521083854417187751e-08; s = s * r2 + 2.75573192239858906526e-06; s = s * r2 - 1.98412698412698412698e-04; s = s * r2 + 8.33333333333333333333e-03; s = s * r2 - 1.66666666666666666667e-01; s = r + r * r2 * s;
        double c = 2.08767569878680989792e-09; c = c * r2 - 2.75573192239858906526e-07; c = c * r2 + 2.48015873015873015873e-05; c = c * r2 - 1.38888888888888888889e-03; c = c * r2 + 4.16666666666666666667e-02; c = c * r2 - 0.5; c = 1.0 + c * r2;
        const int q = ((int)n) & 3;
        const double cc = (q == 0) ? c : (q == 1) ? -s : (q == 2) ? -c : s;
        const double ss = (q == 0) ? s : (q == 1) ? c : (q == 2) ? -s : -c;
        rope[i] = (f32x2){(float)cc, (float)ss};
    }
}
__device__ __forceinline__ void ln_rows(Frame& F, const float* __restrict__ g, const float* __restrict__ b, bool final_out, int nslab) {
    f16* XH = WSP(f16, WS_XH);
    const f32x4 g0 = *(const f32x4*)(g + F.lane * 8), g1 = *(const f32x4*)(g + F.lane * 8 + 4), g2 = *(const f32x4*)(g + 512 + F.lane * 8), g3 = *(const f32x4*)(g + 512 + F.lane * 8 + 4);
    const f32x4 b0 = *(const f32x4*)(b + F.lane * 8), b1 = *(const f32x4*)(b + F.lane * 8 + 4), b2 = *(const f32x4*)(b + 512 + F.lane * 8), b3 = *(const f32x4*)(b + 512 + F.lane * 8 + 4);
    for (int row = F.gw; row < M; row += F.NGW) {
        f16* p = XH + (size_t)row * D + F.lane * 8;
        const f16x8 h0 = *(const f16x8*)p, h1 = *(const f16x8*)(p + 512);
        f32x4 v0 = (f32x4){(float)h0[0], (float)h0[1], (float)h0[2], (float)h0[3]}, v1 = (f32x4){(float)h0[4], (float)h0[5], (float)h0[6], (float)h0[7]};
        f32x4 v2 = (f32x4){(float)h1[0], (float)h1[1], (float)h1[2], (float)h1[3]}, v3 = (f32x4){(float)h1[4], (float)h1[5], (float)h1[6], (float)h1[7]};
        if (row >= MP) {
            f32x4 a0 = (f32x4){0.f, 0.f, 0.f, 0.f}, a1 = a0, a2 = a0, a3 = a0;
            const f16* sp = WSP(f16, WS_SLAB) + (size_t)(row - MP) * D + F.lane * 8;
            for (int s = 0; s < nslab; ++s, sp += (size_t)MS * D) { const f16x8 p0 = *(const f16x8*)sp, p1 = *(const f16x8*)(sp + 512); a0 += up8lo(p0); a1 += up8hi(p0); a2 += up8lo(p1); a3 += up8hi(p1); }
            v0 = v0 * ALPHA + a0; v1 = v1 * ALPHA + a1; v2 = v2 * ALPHA + a2; v3 = v3 * ALPHA + a3;
        }
        f32x4 sv = (v0 + v1) + (v2 + v3);
        const float mean = wave_sum((sv.x + sv.y) + (sv.z + sv.w)) * (1.f / D);
        v0 -= mean; v1 -= mean; v2 -= mean; v3 -= mean;
        f32x4 qv = (v0 * v0 + v1 * v1) + (v2 * v2 + v3 * v3);
        const float rstd = 1.f / sqrtf(wave_sum((qv.x + qv.y) + (qv.z + qv.w)) * (1.f / D) + LN_EPS);
        v0 = v0 * rstd * g0 + b0; v1 = v1 * rstd * g1 + b1; v2 = v2 * rstd * g2 + b2; v3 = v3 * rstd * g3 + b3;
        if (final_out) {
            float* o = (row < MP ? F.out + O_YP + (size_t)row * D : F.out + O_YS + (size_t)(row - MP) * D) + F.lane * 8;
            *(f32x4*)o = v0; *(f32x4*)(o + 4) = v1; *(f32x4*)(o + 512) = v2; *(f32x4*)(o + 516) = v3;
        } else {
            f16x8 o0, o1;
            o0[0] = (f16)v0.x; o0[1] = (f16)v0.y; o0[2] = (f16)v0.z; o0[3] = (f16)v0.w; o0[4] = (f16)v1.x; o0[5] = (f16)v1.y; o0[6] = (f16)v1.z; o0[7] = (f16)v1.w;
            o1[0] = (f16)v2.x; o1[1] = (f16)v2.y; o1[2] = (f16)v2.z; o1[3] = (f16)v2.w; o1[4] = (f16)v3.x; o1[5] = (f16)v3.y; o1[6] = (f16)v3.z; o1[7] = (f16)v3.w;
            *(f16x8*)p = o0; *(f16x8*)(p + 512) = o1;
        }
    }
}
template <class Fn>
__device__ __forceinline__ void sample_gemm(Frame& F, int gws, const f16* A, int lda, const f16* Bt, int ldb, int K, int ncg, const Fn& f) {
    for (int task = gws; task < (MS / 32) * ncg; task += F.NGW)
        small_tile(A, lda, Bt, ldb, K, MP + 32 * (task % (MS / 32)), 64 * (task / (MS / 32)), 0, f, F.lane);
}

constexpr int AT_KS = 72, AT_VS = 264;
constexpr int AT_KOFF = 0, AT_VOFF = 256 * AT_KS * 2;
__device__ __forceinline__ void attn_prompt_unit(Frame& F, int l, int unit) {
    const int g = unit & 1, qb = (unit >> 1) & 63, b = unit >> 7;
    const int R0 = b * SEQ + 128 * qb;
    f16* YRA = WSP(f16, WS_YRA); const f16* KB = WSP(f16, WS_KB); const f16* VB = WSP(f16, WS_VB);
    LAS f16* Ks = (LAS f16*)(F.lds + AT_KOFF); LAS f16* Vt = (LAS f16*)(F.lds + AT_VOFF);
    __syncthreads();
    f16x8 qf2[2][4];
    {   const int lane_ = F.lane, ql_ = lane_ & 31, h_ = lane_ >> 5;
#pragma unroll
        for (int s2 = 0; s2 < 2; ++s2) {
            const int task = F.wave * 2 + s2, hh = task >> 2, sb = task & 3, head = 4 * g + hh;
            const f16* qrow = YRA + (size_t)(R0 + 32 * sb + ql_) * D + 512 + head * 64;
#pragma unroll
            for (int kk = 0; kk < 4; ++kk) qf2[s2][kk] = *(const f16x8*)(qrow + 16 * kk + 8 * h_);
        } }
#pragma unroll
    for (int i = 0; i < 4; ++i) {
        const int idx = F.tid + 512 * i, key = idx >> 3, ch = idx & 7;
        f16x8 kv, vv;
        if (qb == 0 && key < 128) { for (int e = 0; e < 8; ++e) { kv[e] = (f16)0.f; vv[e] = (f16)0.f; } }
        else { const size_t ro = (size_t)(R0 - 128 + key) * 128 + g * 64 + 8 * ch; kv = *(const f16x8*)(KB + ro); vv = *(const f16x8*)(VB + ro); }
        *(LAS f16x8*)(Ks + key * AT_KS + 8 * ch) = kv;
#pragma unroll
        for (int e = 0; e < 8; ++e) Vt[(8 * ch + ((e + ch) & 7)) * AT_VS + key] = vv[e];
    }
    __syncthreads();
    const int lane = F.lane, ql = lane & 31, h = lane >> 5;
#pragma unroll
    for (int s2 = 0; s2 < 2; ++s2) {
        const int task = F.wave * 2 + s2, hh = task >> 2, sb = task & 3, head = 4 * g + hh;
        f16* qrow = YRA + (size_t)(R0 + 32 * sb + ql) * D + 512 + head * 64;
        f16x8 qf[4];
#pragma unroll
        for (int kk = 0; kk < 4; ++kk) qf[kk] = qf2[s2][kk];
        const float sink = F.in[18][l * 8 + head];
        f32x16 sc[5];
#pragma unroll
        for (int kt = 0; kt < 5; ++kt) {
#pragma unroll
            for (int i = 0; i < 16; ++i) sc[kt][i] = 0.f;
            const LAS f16* kp = Ks + (32 * (sb + kt) + ql) * AT_KS + 8 * h;
#pragma unroll
            for (int kk = 0; kk < 4; ++kk) sc[kt] = __builtin_amdgcn_mfma_f32_32x32x16_f16(*(const LAS f16x8*)(kp + 16 * kk), qf[kk], sc[kt], 0, 0, 0);
        }
        float mx = sink;
#pragma unroll
        for (int kt = 0; kt < 5; ++kt) {
            const bool tile_ok = (qb > 0) || (sb + kt >= 4);
#pragma unroll
            for (int r = 0; r < 16; ++r) {
                const int kl = (r & 3) + 8 * (r >> 2) + 4 * h;
                bool ok = tile_ok; if (kt == 0) ok = ok && (kl >= ql); if (kt == 4) ok = ok && (kl <= ql);
                sc[kt][r] = ok ? sc[kt][r] : -INFINITY;
                mx = fmaxf(mx, sc[kt][r]);
            }
        }
        mx = fmaxf(mx, shfl_xor_l(mx, 32, lane));
        float sum = 0.f;
#pragma unroll
        for (int kt = 0; kt < 5; ++kt)
#pragma unroll
            for (int r = 0; r < 16; ++r) { const float p = __expf(sc[kt][r] - mx); sc[kt][r] = p; sum += p; }
        sum += shfl_xor_l(sum, 32, lane);
        const float inv = rcpf_(sum + __expf(sink - mx));
        f32x16 o0, o1;
#pragma unroll
        for (int i = 0; i < 16; ++i) { o0[i] = 0.f; o1[i] = 0.f; }
#pragma unroll
        for (int kt = 0; kt < 5; ++kt)
#pragma unroll
            for (int s = 0; s < 2; ++s) {
                f16x8 pf;
#pragma unroll
                for (int j = 0; j < 8; ++j) pf[j] = (f16)(sc[kt][8 * s + j] * inv);
                const int kc = 32 * (sb + kt) + 16 * s + 4 * h;
                const int vr0 = (ql & ~7) | ((ql + (ql >> 3)) & 7), vr1 = 32 + ((ql & ~7) | ((ql + (ql >> 3) + 4) & 7));
                const LAS f16* v0p = Vt + vr0 * AT_VS + kc; const LAS f16* v1p = Vt + vr1 * AT_VS + kc;
                const f16x4 a0 = *(const LAS f16x4*)v0p, a1 = *(const LAS f16x4*)(v0p + 8), c0 = *(const LAS f16x4*)v1p, c1 = *(const LAS f16x4*)(v1p + 8);
                const f16x8 vf0 = (f16x8){a0.x, a0.y, a0.z, a0.w, a1.x, a1.y, a1.z, a1.w}, vf1 = (f16x8){c0.x, c0.y, c0.z, c0.w, c1.x, c1.y, c1.z, c1.w};
                o0 = __builtin_amdgcn_mfma_f32_32x32x16_f16(vf0, pf, o0, 0, 0, 0);
                o1 = __builtin_amdgcn_mfma_f32_32x32x16_f16(vf1, pf, o1, 0, 0, 0);
            }
#pragma unroll
        for (int gq = 0; gq < 4; ++gq) {
            *(f16x4*)(qrow + 8 * gq + 4 * h) = cvt4((f32x4){o0[4 * gq], o0[4 * gq + 1], o0[4 * gq + 2], o0[4 * gq + 3]});
            *(f16x4*)(qrow + 32 + 8 * gq + 4 * h) = cvt4((f32x4){o1[4 * gq], o1[4 * gq + 1], o1[4 * gq + 2], o1[4 * gq + 3]});
        }
    }
}
__device__ __forceinline__ void attn_sample_task(Frame& F, int l, int task) {
    const int g = task & 1, b = task >> 1, lane = F.lane, ql = lane & 31, h = lane >> 5;
    f16* YRA = WSP(f16, WS_YRA); const f16* KB = WSP(f16, WS_KB); const f16* VB = WSP(f16, WS_VB);
    const float* ck = F.in[4] + ((size_t)l * DECB + b) * WBUF * 128 + g * 64; const float* cv = F.in[5] + ((size_t)l * DECB + b) * WBUF * 128 + g * 64;
    const int rr = ql & 15, qi = rr >> 2, head = 4 * g + (rr & 3);
    f16* qrow = YRA + (size_t)(MP + 4 * b + qi) * D + 512 + head * 64;
    f16x8 qf[4];
#pragma unroll
    for (int kk = 0; kk < 4; ++kk) qf[kk] = *(const f16x8*)(qrow + 16 * kk + 8 * h);
    const float sink = F.in[18][l * 8 + head];
    f32x16 sc[5];
#pragma unroll
    for (int kt = 0; kt < 5; ++kt) {
#pragma unroll
        for (int i = 0; i < 16; ++i) sc[kt][i] = 0.f;
        const int key = 32 * kt + ql;
#pragma unroll
        for (int kk = 0; kk < 4; ++kk) {
            f16x8 kf;
            if (key < WBUF) { const f32x4 a = *(const f32x4*)(ck + (size_t)key * 128 + 16 * kk + 8 * h), c2 = *(const f32x4*)(ck + (size_t)key * 128 + 16 * kk + 8 * h + 4);
                kf = (f16x8){(f16)a.x, (f16)a.y, (f16)a.z, (f16)a.w, (f16)c2.x, (f16)c2.y, (f16)c2.z, (f16)c2.w}; }
            else if (key < WBUF + DECT) kf = *(const f16x8*)(KB + (size_t)(MP + 4 * b + key - WBUF) * 128 + g * 64 + 16 * kk + 8 * h);
            else kf = (f16x8){(f16)0.f, (f16)0.f, (f16)0.f, (f16)0.f, (f16)0.f, (f16)0.f, (f16)0.f, (f16)0.f};
            sc[kt] = __builtin_amdgcn_mfma_f32_32x32x16_f16(kf, qf[kk], sc[kt], 0, 0, 0);
        }
    }
    float mx = sink;
#pragma unroll
    for (int kt = 0; kt < 5; ++kt)
#pragma unroll
        for (int r = 0; r < 16; ++r) {
            const int key = 32 * kt + (r & 3) + 8 * (r >> 2) + 4 * h;
            const bool ok = key < WBUF ? (key >= qi) : (key < WBUF + DECT && key - WBUF <= qi);
            sc[kt][r] = ok ? sc[kt][r] : -INFINITY; mx = fmaxf(mx, sc[kt][r]);
        }
    mx = fmaxf(mx, shfl_xor_l(mx, 32, lane));
    float sum = 0.f;
#pragma unroll
    for (int kt = 0; kt < 5; ++kt)
#pragma unroll
        for (int r = 0; r < 16; ++r) { const float p = __expf(sc[kt][r] - mx); sc[kt][r] = p; sum += p; }
    sum += shfl_xor_l(sum, 32, lane);
    const float inv = rcpf_(sum + __expf(sink - mx));
    f32x16 o0, o1;
#pragma unroll
    for (int i = 0; i < 16; ++i) { o0[i] = 0.f; o1[i] = 0.f; }
#pragma unroll
    for (int kt = 0; kt < 5; ++kt)
#pragma unroll
        for (int s = 0; s < 2; ++s) {
            f16x8 pf, vf0, vf1;
#pragma unroll
            for (int j = 0; j < 8; ++j) {
                pf[j] = (f16)(sc[kt][8 * s + j] * inv);
                const int key = 32 * kt + 16 * s + 8 * (j >> 2) + 4 * h + (j & 3);
                float x0 = 0.f, x1 = 0.f;
                if (key < WBUF) { x0 = cv[(size_t)key * 128 + ql]; x1 = cv[(size_t)key * 128 + 32 + ql]; }
                else if (key < WBUF + DECT) { const f16* vp = VB + (size_t)(MP + 4 * b + key - WBUF) * 128 + g * 64; x0 = (float)vp[ql]; x1 = (float)vp[32 + ql]; }
                vf0[j] = (f16)x0; vf1[j] = (f16)x1;
            }
            o0 = __builtin_amdgcn_mfma_f32_32x32x16_f16(vf0, pf, o0, 0, 0, 0);
            o1 = __builtin_amdgcn_mfma_f32_32x32x16_f16(vf1, pf, o1, 0, 0, 0);
        }
    if (ql < 16) {
#pragma unroll
        for (int gq = 0; gq < 4; ++gq) {
            *(f16x4*)(qrow + 8 * gq + 4 * h) = cvt4((f32x4){o0[4 * gq], o0[4 * gq + 1], o0[4 * gq + 2], o0[4 * gq + 3]});
            *(f16x4*)(qrow + 32 + 8 * gq + 4 * h) = cvt4((f32x4){o1[4 * gq], o1[4 * gq + 1], o1[4 * gq + 2], o1[4 * gq + 3]});
        }
    }
}

template <int T> struct RL { static constexpr int W = 0, AL = T * 256, BE = 2 * T * 256, RK = 3 * T * 256, V = RK + T * 256, SIZE = V + T * 128; };
struct RLP { static constexpr int TP = 272, VP = 144, W = 0, AL = 8 * TP, BE = 16 * TP, RK = 24 * TP, V = 32 * TP, SIZE = V + 8 * VP; };
constexpr int SH_P = 264, RAW_OFF = 8 * RLP::SIZE, RAW_SZ = 32768, SHP_OFF = RAW_OFF + 2 * RAW_SZ, SHS_OFF = 8 * RL<16>::SIZE;
constexpr int PRM_OFF = SHP_OFF + 8 * SH_P * 2, PR_DB = 0, PR_MU = 2048, PR_IB = PR_MU + 3584, PR_KK = PR_IB + 1024, PR_KA = PR_KK + 1024, PR_RK = PR_KA + 1024, PRM_SZ = PR_RK + 1024;
static_assert(PRM_OFF + PRM_SZ <= MISC_OFF && SHS_OFF + 16 * SH_P * 2 <= MISC_OFF, "scan LDS map");
#define CFENCE() asm volatile("" ::: "memory")
constexpr int RAWS_OFF = 81920, PRMS_OFF = 102400;
constexpr int SXT_OFF = PRMS_OFF + 9728;
static_assert(SXT_OFF + 8 * 4352 <= 8 * RL<16>::SIZE, "sample unit LDS map");
constexpr int SGS_OFF = 8 * RL<4>::SIZE;
struct RwkvP { const f16* ZR; f16* YRA; f16* GG; const f16* lora; const float *mu, *dbase, *ibase, *kk_, *ka_, *rk_, *sshift; };
__device__ __forceinline__ RwkvP rwkv_params(Frame& F, int l) {
    RwkvP P; P.ZR = WSP(f16, WS_ZR); P.YRA = WSP(f16, WS_YRA); P.GG = WSP(f16, WS_GGS); P.lora = (const f16*)(F.ws + WS_LORA + (size_t)l * LORA_STRIDE);
    P.mu = F.in[7] + (size_t)l * SHW; P.dbase = F.in[8] + (size_t)l * RW; P.ibase = F.in[10] + (size_t)l * RW; P.kk_ = F.in[13] + (size_t)l * RW; P.ka_ = F.in[14] + (size_t)l * RW;
    P.rk_ = F.in[15] + (size_t)l * RW; P.sshift = F.in[3] + (size_t)l * DECB * SHW; return P;
}
template <bool SAMPLE>
__device__ __forceinline__ f32x4 par4(const float* g, const LAS unsigned char* prm, int off, int i) {
    return up4(*(const LAS f16x4*)(prm + off + 2 * i));
}
template <bool SAMPLE>
__device__ __forceinline__ f32x4 zs4(const RwkvP& P, const LAS f16* raw, const LAS unsigned char* prm, int row, int tl, int col) {
    const f32x4 z = up4(*(const LAS f16x4*)(raw + (tl + 1) * SHW + col));
    f32x4 pv = up4(*(const LAS f16x4*)(raw + tl * SHW + col));
    if (!SAMPLE && (row & (SEQ - 1)) == 0) pv = (f32x4){0.f, 0.f, 0.f, 0.f};
    const f32x4 m = up4(*(const LAS f16x4*)(prm + PR_MU + 2 * col));
    return z + (pv - z) * m;
}
__device__ __forceinline__ float lora_act(float x, int col) {
    const float sc = col < 64 ? 2.0f : 1.0f, cc = col < 64 ? -1.0f : 0.0f;
    const float y = sc * rcpf_(1.0f + __expf(-sc * x)) + cc;
    return (col >= 64 && col < 128) ? x : y;
}
template <bool SAMPLE>
__device__ __forceinline__ void rwkv_prepA(const RwkvP& P, int wave, int row0, const LAS f16* raw, const LAS unsigned char* prm, LAS f16* sh, int lane) {
    if (SAMPLE) {
        if (wave >= 2) return;
        const int tk = 2 * wave + (lane >> 5), c8 = 8 * (lane & 31), row = row0 + tk;
        const f32x4 a = zs4<true>(P, raw, prm, row, tk, 3 * RW + c8), b = zs4<true>(P, raw, prm, row, tk, 3 * RW + c8 + 4);
        f16x8 o;
#pragma unroll
        for (int e = 0; e < 8; ++e) o[e] = (f16)lora_act(e < 4 ? a[e & 3] : b[e & 3], c8);
        *(LAS f16x8*)(sh + tk * SH_P + c8) = o;
    } else {
        const int tk = wave, c4 = 4 * lane, row = row0 + tk;
        const f32x4 a = zs4<false>(P, raw, prm, row, tk, 3 * RW + c4);
        f16x4 o;
#pragma unroll
        for (int e = 0; e < 4; ++e) o[e] = (f16)lora_act(a[e], c4);
        *(LAS f16x4*)(sh + tk * SH_P + c4) = o;
    }
}
template <bool SAMPLE, int T>
__device__ __forceinline__ void rwkv_prepB(const RwkvP& P, int h, int row0, const LAS f16* raw, const LAS unsigned char* prm, const LAS f16* shb, LAS unsigned char* wl, int lane,
                                           const f16x8 (&wd)[4][2], const f16x8 (&wg)[4][4], const f16x8 (&wi)[4][2]) {
    typedef RL<T> L;
    const int tl = (lane & 15) & (T - 1), q = lane >> 4, row = row0 + tl;
    const bool st = SAMPLE || ((lane & 15) < T);
    const LAS f16* sh = shb + tl * SH_P + 8 * q;
    f32x4 acc[4];
#pragma unroll
    for (int nt = 0; nt < 4; ++nt) acc[nt] = (f32x4){0.f, 0.f, 0.f, 0.f};
#pragma unroll
    for (int kk = 0; kk < 2; ++kk) { const f16x8 fr = *(const LAS f16x8*)(sh + 32 * kk);
#pragma unroll
        for (int nt = 0; nt < 4; ++nt) acc[nt] = __builtin_amdgcn_mfma_f32_16x16x32_f16(wd[nt][kk], fr, acc[nt], 0, 0, 0); }
#pragma unroll
    for (int nt = 0; nt < 4; ++nt) {
        const int c4 = 16 * nt + 4 * q;
        const f32x4 sg = sig4(*(const LAS f32x4*)(prm + PR_DB + 4 * (h * 64 + c4)) + acc[nt]);
        f32x4 w; w.x = __expf(-0.60653065971263342f * sg.x); w.y = __expf(-0.60653065971263342f * sg.y); w.z = __expf(-0.60653065971263342f * sg.z); w.w = __expf(-0.60653065971263342f * sg.w);
        if (st) *(LAS f32x4*)(wl + L::W + (tl * 64 + c4) * 4) = w;
    }
    if (!SAMPLE) CFENCE();
    if (SAMPLE) {
#pragma unroll
        for (int nt = 0; nt < 4; ++nt) acc[nt] = (f32x4){0.f, 0.f, 0.f, 0.f};
#pragma unroll
        for (int kk = 0; kk < 4; ++kk) { const f16x8 fr = *(const LAS f16x8*)(sh + 128 + 32 * kk);
#pragma unroll
            for (int nt = 0; nt < 4; ++nt) acc[nt] = __builtin_amdgcn_mfma_f32_16x16x32_f16(wg[nt][kk], fr, acc[nt], 0, 0, 0); }
        if ((lane & 15) < T) {
#pragma unroll
            for (int nt = 0; nt < 4; ++nt) *(LAS f16x4*)(wl + SGS_OFF + (tl * 64 + 16 * nt + 4 * q) * 2) = cvt4(acc[nt]); }
    }
#pragma unroll
    for (int nt = 0; nt < 4; ++nt) acc[nt] = (f32x4){0.f, 0.f, 0.f, 0.f};
#pragma unroll
    for (int kk = 0; kk < 2; ++kk) { const f16x8 fr = *(const LAS f16x8*)(sh + 64 + 32 * kk);
#pragma unroll
        for (int nt = 0; nt < 4; ++nt) acc[nt] = __builtin_amdgcn_mfma_f32_16x16x32_f16(wi[nt][kk], fr, acc[nt], 0, 0, 0); }
    float ssq = 0.f, bon = 0.f;
#pragma unroll
    for (int nt = 0; nt < 4; ++nt) {
        const int c4 = 16 * nt + 4 * q, ch = h * 64 + c4;
        const f32x4 av = sig4(par4<SAMPLE>(P.ibase, prm, PR_IB, ch) + acc[nt]);
        const f32x4 rv = zs4<SAMPLE>(P, raw, prm, row, tl, ch), kx = zs4<SAMPLE>(P, raw, prm, row, tl, RW + ch), vv = zs4<SAMPLE>(P, raw, prm, row, tl, 2 * RW + ch);
        const f32x4 kkv = kx * par4<SAMPLE>(P.kk_, prm, PR_KK, ch);
        const f32x4 kp = kx * (1.0f + (av - 1.0f) * par4<SAMPLE>(P.ka_, prm, PR_KA, ch));
        const f32x4 s2 = kkv * kkv; ssq += (s2.x + s2.y) + (s2.z + s2.w);
        const f32x4 b2 = rv * kp * par4<SAMPLE>(P.rk_, prm, PR_RK, ch); bon += (b2.x + b2.y) + (b2.z + b2.w);
        if (st) {
            *(LAS f32x4*)(wl + L::AL + (tl * 64 + c4) * 4) = kkv;
            *(LAS f32x4*)(wl + L::BE + (tl * 64 + c4) * 4) = av;
            *(LAS f16x4*)(wl + L::RK + (tl * 64 + c4) * 4) = cvt4(rv);
            *(LAS f16x4*)(wl + L::RK + (tl * 64 + c4) * 4 + 8) = cvt4(kp);
            *(LAS f16x4*)(wl + L::V + (tl * 64 + c4) * 2) = cvt4(vv);
        }
        if (!SAMPLE) CFENCE();
    }
    ssq += shfl_xor_l(ssq, 16, lane); ssq += shfl_xor_l(ssq, 32, lane); bon += shfl_xor_l(bon, 16, lane); bon += shfl_xor_l(bon, 32, lane);
    const float inv = rsqf_(fmaxf(ssq, 1e-24f));
    LDS_WAIT();
    if (st) {
#pragma unroll
        for (int nt = 0; nt < 4; ++nt) {
            const int c4 = 16 * nt + 4 * q;
            const f32x4 kn = *(const LAS f32x4*)(wl + L::AL + (tl * 64 + c4) * 4) * inv, av = *(const LAS f32x4*)(wl + L::BE + (tl * 64 + c4) * 4);
            *(LAS f32x4*)(wl + L::AL + (tl * 64 + c4) * 4) = -kn;
            *(LAS f32x4*)(wl + L::BE + (tl * 64 + c4) * 4) = kn * av;
            if (!SAMPLE) { const f32x4 vv = up4(*(const LAS f16x4*)(wl + L::V + (tl * 64 + c4) * 2));
                *(f16x4*)(P.YRA + (size_t)row * D + h * 64 + c4) = cvt4(vv * bon); }
        }
        if (SAMPLE && q == 0) *(LAS float*)(wl + SGS_OFF + T * 128 + 4 * tl) = bon;
    }
    CFENCE();
}
template <bool HAS_P, int T>
__device__ __forceinline__ void scan_step(float (&SP)[64], float (&SU)[64], const LAS unsigned char* wl, int t, float vv, float& yp, float& yu) {
    typedef RL<T> L;
    const LAS unsigned char* pa = wl + L::AL + t * 256; const LAS unsigned char* pw = wl + L::W + t * 256; const LAS unsigned char* pb = wl + L::BE + t * 256;
    const LAS unsigned char* pk = wl + L::RK + t * 256;
    constexpr int DA = 4, DB = 2;
    f32x4 A[DA], W[DB], B[DB]; f16x8 RK[DB];
#pragma unroll
    for (int i = 0; i < DA; ++i) A[i] = *(const LAS f32x4*)(pa + 16 * i);
    float saP = 0.f, saU = 0.f;
#pragma unroll
    for (int g = 0; g < 16; ++g) {
        const f32x4 a = A[g % DA];
        if (g + DA < 16) A[g % DA] = *(const LAS f32x4*)(pa + 16 * (g + DA));
#pragma unroll
        for (int e = 0; e < 4; ++e) { saU = fmaf(SU[4 * g + e], a[e], saU); if (HAS_P) saP = fmaf(SP[4 * g + e], a[e], saP); }
        if (g == 16 - DB) {
#pragma unroll
            for (int i = 0; i < DB; ++i) { W[i] = *(const LAS f32x4*)(pw + 16 * i); B[i] = *(const LAS f32x4*)(pb + 16 * i); RK[i] = *(const LAS f16x8*)(pk + 16 * i); }
        }
        CFENCE();
    }
    float yP = 0.f, yU = 0.f;
#pragma unroll
    for (int g = 0; g < 16; ++g) {
        const f32x4 w = W[g % DB], be = B[g % DB]; const f16x8 rk = RK[g % DB];
        if (g + DB < 16) { W[g % DB] = *(const LAS f32x4*)(pw + 16 * (g + DB)); B[g % DB] = *(const LAS f32x4*)(pb + 16 * (g + DB)); RK[g % DB] = *(const LAS f16x8*)(pk + 16 * (g + DB)); }
#pragma unroll
        for (int e = 0; e < 4; ++e) {
            const int k = 4 * g + e;
            float u = fmaf(vv, (float)rk[4 + e], be[e] * saU);
            SU[k] = fmaf(SU[k], w[e], u);
            yU = fmaf(SU[k], (float)rk[e], yU);
            if (HAS_P) { SP[k] = fmaf(SP[k], w[e], be[e] * saP); yP = fmaf(SP[k], (float)rk[e], yP); }
        }
        CFENCE();
    }
    yp = yP; yu = yU;
}
__device__ __forceinline__ float quad_sum(float v) {
    v += __builtin_bit_cast(float, __builtin_amdgcn_update_dpp(0, __builtin_bit_cast(int, v), 0xB1, 0xf, 0xf, true));
    v += __builtin_bit_cast(float, __builtin_amdgcn_update_dpp(0, __builtin_bit_cast(int, v), 0x4E, 0xf, 0xf, true));
    return v;
}
__device__ __forceinline__ f32x2 fma2(f32x2 a, f32x2 b, f32x2 c) { return __builtin_elementwise_fma(a, b, c); }
__device__ __forceinline__ void scan_step_q(f32x2 (&SP)[4][8], f32x2 (&SU)[4][8], LAS unsigned char* wl, int t, int Q, int sub) {
    typedef RLP L;
    const LAS unsigned char* pa = wl + L::AL + t * L::TP + 64 * sub; const LAS unsigned char* pw = wl + L::W + t * L::TP + 64 * sub; const LAS unsigned char* pb = wl + L::BE + t * L::TP + 64 * sub;
    const LAS unsigned char* pk = wl + L::RK + t * L::TP + 64 * sub;
    f32x4 A[4], W[2], B[2]; f16x8 RK[2];
#pragma unroll
    for (int i = 0; i < 4; ++i) A[i] = *(const LAS f32x4*)(pa + 16 * i);
    const f16x4 v4 = *(const LAS f16x4*)(wl + L::V + t * L::VP + 8 * Q);
    f32x2 dP[4], dU[4];
#pragma unroll
    for (int r = 0; r < 4; ++r) { dP[r] = (f32x2){0.f, 0.f}; dU[r] = (f32x2){0.f, 0.f}; }
#pragma unroll
    for (int g = 0; g < 4; ++g) {
        const f32x2 alo = A[g].xy, ahi = A[g].zw;
#pragma unroll
        for (int r = 0; r < 4; ++r) { dU[r] = fma2(SU[r][2 * g], alo, dU[r]); dP[r] = fma2(SP[r][2 * g], alo, dP[r]); }
#pragma unroll
        for (int r = 0; r < 4; ++r) { dU[r] = fma2(SU[r][2 * g + 1], ahi, dU[r]); dP[r] = fma2(SP[r][2 * g + 1], ahi, dP[r]); }
        if (g == 1) {
#pragma unroll
            for (int i = 0; i < 2; ++i) { W[i] = *(const LAS f32x4*)(pw + 16 * i); B[i] = *(const LAS f32x4*)(pb + 16 * i); RK[i] = *(const LAS f16x8*)(pk + 16 * i); }
        }
        CFENCE();
    }
    float saP[4], saU[4], vv[4];
#pragma unroll
    for (int r = 0; r < 4; ++r) { saU[r] = quad_sum(dU[r].x + dU[r].y); saP[r] = quad_sum(dP[r].x + dP[r].y); vv[r] = (float)v4[r]; }
    f32x2 yP[4], yU[4];
#pragma unroll
    for (int r = 0; r < 4; ++r) { yP[r] = (f32x2){0.f, 0.f}; yU[r] = (f32x2){0.f, 0.f}; }
#pragma unroll
    for (int g = 0; g < 4; ++g) {
        const f32x4 w = W[g & 1], be = B[g & 1]; const f16x8 rk = RK[g & 1];
        if (g + 2 < 4) { W[g & 1] = *(const LAS f32x4*)(pw + 16 * (g + 2)); B[g & 1] = *(const LAS f32x4*)(pb + 16 * (g + 2)); RK[g & 1] = *(const LAS f16x8*)(pk + 16 * (g + 2)); }
#pragma unroll
        for (int hf = 0; hf < 2; ++hf) {
            const f32x2 wh = hf ? w.zw : w.xy, bh = hf ? be.zw : be.xy;
            const f32x2 rh = (f32x2){(float)rk[2 * hf], (float)rk[2 * hf + 1]}, kh = (f32x2){(float)rk[4 + 2 * hf], (float)rk[5 + 2 * hf]};
            const int cp = 2 * g + hf;
#pragma unroll
            for (int r = 0; r < 4; ++r) {
                const f32x2 tu = fma2(kh, (f32x2){vv[r], vv[r]}, SU[r][cp] * wh), tp = SP[r][cp] * wh;
                SU[r][cp] = fma2(bh, (f32x2){saU[r], saU[r]}, tu);
                yU[r] = fma2(SU[r][cp], rh, yU[r]);
                SP[r][cp] = fma2(bh, (f32x2){saP[r], saP[r]}, tp);
                yP[r] = fma2(SP[r][cp], rh, yP[r]);
            }
        }
        CFENCE();
    }
    f32x4 yp, yu;
#pragma unroll
    for (int r = 0; r < 4; ++r) { yp[r] = quad_sum(yP[r].x + yP[r].y); yu[r] = quad_sum(yU[r].x + yU[r].y); }
    if (sub == 0) {
        *(LAS f16x4*)(wl + L::W + t * L::TP + 8 * Q) = cvt4(yp);
        *(LAS f16x4*)(wl + L::W + t * L::TP + 128 + 8 * Q) = cvt4(yu);
    }
}
__device__ __forceinline__ void scan_stage(const f16* ZR, int rowm1, LAS unsigned char* dst, int wave, int lane) {
    const char* g = (const char*)(ZR + (ptrdiff_t)rowm1 * SHW);
#pragma unroll
    for (int i = 0; i < 4; ++i) { const int blk = i * 8 + wave;
        __builtin_amdgcn_global_load_lds((const unsigned*)(g + (blk * 64 + lane) * 16), (LAS unsigned*)(dst + blk * 1024), 16, 0, 0); }
}
constexpr int SH64_P = 136;
__device__ __forceinline__ void scan_stage_w(const f16* ZR, int rowm1, int h, LAS unsigned char* dst, int lane) {
#pragma unroll
    for (int i = 0; i < 4; ++i) {
        int ci = i * 64 + lane; ci = ci < 225 ? ci : 224;
        const int row = ci / 25; int seg = ci % 25; seg = seg < 24 ? seg : 23;
        const f16* g = ZR + (ptrdiff_t)(rowm1 + row) * SHW + (seg >> 3) * RW + h * 64 + 8 * (seg & 7);
        __builtin_amdgcn_global_load_lds((const unsigned*)g, (LAS unsigned*)(dst + i * 1024), 16, 0, 0);
    }
}
__device__ __forceinline__ f32x4 zsw(const LAS f16* rw, const LAS unsigned char* prm, int h, int row, int tl, int a, int c4) {
    const f32x4 z = up4(*(const LAS f16x4*)(rw + (tl + 1) * 192 + a * 64 + c4));
    f32x4 pv = up4(*(const LAS f16x4*)(rw + tl * 192 + a * 64 + c4));
    if ((row & (SEQ - 1)) == 0) pv = (f32x4){0.f, 0.f, 0.f, 0.f};
    const f32x4 m = up4(*(const LAS f16x4*)(prm + PR_MU + 2 * (a * RW + h * 64 + c4)));
    return z + (pv - z) * m;
}
__device__ __forceinline__ void rwkv_prep8(const RwkvP& P, int h, int row0, const LAS f16* raw, const LAS unsigned char* prm, LAS unsigned char* wl, int lane, const f16x8 lw, const f16x8 aa) {
    typedef RLP L;
    const int tl = lane & 7, q = lane >> 3, row = row0 + tl;
    const LAS f16* zr = raw + tl * 200 + 8 * q;
    const LAS unsigned char* pc = prm + 2 * (h * 64 + 8 * q);
    const f16x8 zr_ = *(const LAS f16x8*)(zr + 200), pr_ = *(const LAS f16x8*)zr, mr_ = *(const LAS f16x8*)(pc + PR_MU);
    const f16x8 zk_ = *(const LAS f16x8*)(zr + 200 + 64), pk_ = *(const LAS f16x8*)(zr + 64), mk_ = *(const LAS f16x8*)(pc + PR_MU + 2 * RW);
    __builtin_amdgcn_sched_barrier(0);
    const bool first = (row & (SEQ - 1)) == 0;
    f32x4 rv[2], kx[2], vv[2];
#pragma unroll
    for (int hh = 0; hh < 2; ++hh) {
        const f32x4 z0 = hh ? up8hi(zr_) : up8lo(zr_), m0 = hh ? up8hi(mr_) : up8lo(mr_); f32x4 p0 = hh ? up8hi(pr_) : up8lo(pr_); if (first) p0 = (f32x4){0.f, 0.f, 0.f, 0.f};
        rv[hh] = z0 + (p0 - z0) * m0;
        const f32x4 z1 = hh ? up8hi(zk_) : up8lo(zk_), m1 = hh ? up8hi(mk_) : up8lo(mk_); f32x4 p1 = hh ? up8hi(pk_) : up8lo(pk_); if (first) p1 = (f32x4){0.f, 0.f, 0.f, 0.f};
        kx[hh] = z1 + (p1 - z1) * m1;
    }
    __builtin_amdgcn_sched_barrier(0);
    const f16x8 zv_ = *(const LAS f16x8*)(zr + 200 + 128), pv_ = *(const LAS f16x8*)(zr + 128), mv_ = *(const LAS f16x8*)(pc + PR_MU + 4 * RW);
    const f16x8 ckk = *(const LAS f16x8*)(pc + PR_KK), cka = *(const LAS f16x8*)(pc + PR_KA), crk = *(const LAS f16x8*)(pc + PR_RK);
    __builtin_amdgcn_sched_barrier(0);
    float ssq = 0.f, bon = 0.f;
#pragma unroll
    for (int hh = 0; hh < 2; ++hh) {
        const int c4 = 8 * q + 4 * hh;
        const f32x4 z2 = hh ? up8hi(zv_) : up8lo(zv_), m2 = hh ? up8hi(mv_) : up8lo(mv_); f32x4 p2 = hh ? up8hi(pv_) : up8lo(pv_); if (first) p2 = (f32x4){0.f, 0.f, 0.f, 0.f};
        vv[hh] = z2 + (p2 - z2) * m2;
        const f32x4 av = hh ? up8hi(aa) : up8lo(aa), lwv = hh ? up8hi(lw) : up8lo(lw);
        f32x4 w; w.x = __expf(lwv.x); w.y = __expf(lwv.y); w.z = __expf(lwv.z); w.w = __expf(lwv.w);
        const f32x4 kkv = kx[hh] * (hh ? up8hi(ckk) : up8lo(ckk));
        const f32x4 kp = kx[hh] * (1.0f + (av - 1.0f) * (hh ? up8hi(cka) : up8lo(cka)));
        const f32x4 s2 = kkv * kkv; ssq += (s2.x + s2.y) + (s2.z + s2.w);
        const f32x4 b2 = rv[hh] * kp * (hh ? up8hi(crk) : up8lo(crk)); bon += (b2.x + b2.y) + (b2.z + b2.w);
        *(LAS f32x4*)(wl + L::W + tl * L::TP + c4 * 4) = w;
        *(LAS f32x4*)(wl + L::AL + tl * L::TP + c4 * 4) = kkv;
        *(LAS f32x4*)(wl + L::BE + tl * L::TP + c4 * 4) = av;
        *(LAS f16x4*)(wl + L::RK + tl * L::TP + c4 * 4) = cvt4(rv[hh]);
        *(LAS f16x4*)(wl + L::RK + tl * L::TP + c4 * 4 + 8) = cvt4(kp);
    }
    *(LAS f16x8*)(wl + L::V + tl * L::VP + 16 * q) = cvt8(vv[0], vv[1]);
    ssq += shfl_xor_l(ssq, 8, lane); bon += shfl_xor_l(bon, 8, lane); ssq += shfl_xor_l(ssq, 16, lane); bon += shfl_xor_l(bon, 16, lane); ssq += shfl_xor_l(ssq, 32, lane); bon += shfl_xor_l(bon, 32, lane);
    const float inv = rsqf_(fmaxf(ssq, 1e-24f));
    LDS_WAIT();
    {
        const f32x4 k0 = *(const LAS f32x4*)(wl + L::AL + tl * L::TP + 32 * q), k1 = *(const LAS f32x4*)(wl + L::AL + tl * L::TP + 32 * q + 16);
        const f32x4 a0 = *(const LAS f32x4*)(wl + L::BE + tl * L::TP + 32 * q), a1 = *(const LAS f32x4*)(wl + L::BE + tl * L::TP + 32 * q + 16);
        __builtin_amdgcn_sched_barrier(0);
        const f32x4 kn0 = k0 * inv, kn1 = k1 * inv;
        *(LAS f32x4*)(wl + L::AL + tl * L::TP + 32 * q) = -kn0; *(LAS f32x4*)(wl + L::AL + tl * L::TP + 32 * q + 16) = -kn1;
        *(LAS f32x4*)(wl + L::BE + tl * L::TP + 32 * q) = kn0 * a0; *(LAS f32x4*)(wl + L::BE + tl * L::TP + 32 * q + 16) = kn1 * a1;
    }
    *(f16x8*)(P.YRA + (size_t)row * D + h * 64 + 8 * q) = cvt8(vv[0] * bon, vv[1] * bon);
    CFENCE();
}
__device__ __forceinline__ void scan_unit_prompt(Frame& F, int l, int unit) {
    typedef RLP L;
    const int h = F.wave; int lane = F.lane; asm volatile("" : "+v"(lane)); const int tid = h * 64 + lane;
    const RwkvP P = rwkv_params(F, l);
    LAS unsigned char* wl = F.lds + h * L::SIZE;
    const int row0 = (unit >> 7) * SEQ + (unit & 127) * CH;
    f16* ysc = (f16*)(F.ws + WS_YSC) + ((size_t)unit * 8 + h) * 8192;
    f16* lws = WSP(f16, WS_MIX) + ((size_t)F.bid * 8 + h) * 8192;
    const LAS unsigned char* prm = F.lds + PRM_OFF;
    __syncthreads();
    {
        LAS unsigned char* pw_ = F.lds + PRM_OFF; const int t4 = 4 * tid;
        if (t4 < RW) { *(LAS f32x4*)(pw_ + PR_DB + 4 * t4) = *(const f32x4*)(P.dbase + t4); *(LAS f16x4*)(pw_ + PR_IB + 2 * t4) = cvt4(*(const f32x4*)(P.ibase + t4)); *(LAS f16x4*)(pw_ + PR_KK + 2 * t4) = cvt4(*(const f32x4*)(P.kk_ + t4));
                       *(LAS f16x4*)(pw_ + PR_KA + 2 * t4) = cvt4(*(const f32x4*)(P.ka_ + t4)); *(LAS f16x4*)(pw_ + PR_RK + 2 * t4) = cvt4(*(const f32x4*)(P.rk_ + t4)); }
        if (t4 < SHW) *(LAS f16x4*)(pw_ + PR_MU + 2 * t4) = cvt4(*(const f32x4*)(P.mu + t4));
    }
    {
        LAS f16* sh = (LAS f16*)F.lds;
        const int tk = tid >> 3, c16 = 16 * (tid & 7), row = row0 + tk, col = 3 * RW + c16;
#pragma unroll
        for (int hh = 0; hh < 2; ++hh) {
            const f16x8 z = *(const f16x8*)(P.ZR + (size_t)row * SHW + col + 8 * hh);
            f16x8 pv; if ((row & (SEQ - 1)) == 0) { for (int e = 0; e < 8; ++e) pv[e] = (f16)0.f; } else pv = *(const f16x8*)(P.ZR + (size_t)(row - 1) * SHW + col + 8 * hh);
            const f32x4 m0 = *(const f32x4*)(P.mu + col + 8 * hh), m1 = *(const f32x4*)(P.mu + col + 8 * hh + 4);
            f16x8 o;
#pragma unroll
            for (int e = 0; e < 8; ++e) { const float zz = (float)z[e], pp = (float)pv[e], mm = e < 4 ? m0[e & 3] : m1[e & 3]; o[e] = (f16)lora_act(zz + (pp - zz) * mm, c16); }
            *(LAS f16x8*)(sh + tk * SH64_P + c16 + 8 * hh) = o;
        }
    }
    LDS_WAIT(); __syncthreads();
    {
        const unsigned tl = lane & 15, q = lane >> 4;
        const f16* DUb = P.lora + (size_t)h * 64 * 64; const f16* IUb = DUb + 512 * 64;
        const unsigned wo = tl * 64u + 8u * q;
        f16x8 wd[4][2], wi[4][2];
#pragma unroll
        for (int nt = 0; nt < 4; ++nt)
#pragma unroll
            for (int kk = 0; kk < 2; ++kk) { wd[nt][kk] = *(const f16x8*)(DUb + (wo + (unsigned)(nt * 1024 + 32 * kk))); wi[nt][kk] = *(const f16x8*)(IUb + (wo + (unsigned)(nt * 1024 + 32 * kk))); }
#pragma unroll 1
        for (int tt = 0; tt < 4; ++tt) {
            const LAS f16* sh = (const LAS f16*)F.lds + (16 * tt + tl) * SH64_P + 8 * q;
            const f16x8 fd0 = *(const LAS f16x8*)(sh), fd1 = *(const LAS f16x8*)(sh + 32), fi0 = *(const LAS f16x8*)(sh + 64), fi1 = *(const LAS f16x8*)(sh + 96);
            const unsigned so = (16u * tt + tl) * 64u + 4u * q;
#pragma unroll
            for (int nt = 0; nt < 4; ++nt) {
                const int c4 = 16 * nt + 4 * q;
                f32x4 ad = (f32x4){0.f, 0.f, 0.f, 0.f}, ai = ad;
                ad = __builtin_amdgcn_mfma_f32_16x16x32_f16(wd[nt][0], fd0, ad, 0, 0, 0); ad = __builtin_amdgcn_mfma_f32_16x16x32_f16(wd[nt][1], fd1, ad, 0, 0, 0);
                ai = __builtin_amdgcn_mfma_f32_16x16x32_f16(wi[nt][0], fi0, ai, 0, 0, 0); ai = __builtin_amdgcn_mfma_f32_16x16x32_f16(wi[nt][1], fi1, ai, 0, 0, 0);
                const f32x4 lw = sig4(*(const LAS f32x4*)(prm + PR_DB + 4 * (h * 64 + c4)) + ad) * (-0.60653065971263342f);
                const f32x4 av = sig4(up4(*(const LAS f16x4*)(prm + PR_IB + 2 * (h * 64 + c4))) + ai);
                *(f16x4*)(lws + (so + 16u * nt)) = cvt4(lw);
                *(f16x4*)(lws + 4096 + (so + 16u * nt)) = cvt4(av);
            }
        }
    }
    VM_WAIT(); __syncthreads();
    LAS unsigned char* rawb = F.lds + RAW_OFF + h * 8192;
    scan_stage_w(P.ZR, row0 - 1, h, rawb, lane);
    f16x8 lw, aa;
    {   const unsigned lo = (unsigned)((lane & 7) * 64 + 8 * (lane >> 3));
        lw = *(const f16x8*)(lws + lo); aa = *(const f16x8*)(lws + 4096 + lo); }
    f32x2 SP[4][8], SU[4][8];
    { int l0 = lane; asm volatile("" : "+v"(l0));
      const int d0 = 4 * (l0 >> 2) - 16 * (l0 & 3);
#pragma unroll
      for (int r = 0; r < 4; ++r)
#pragma unroll
        for (int cp = 0; cp < 8; ++cp) { SP[r][cp] = (f32x2){(d0 + r == 2 * cp) ? 1.f : 0.f, (d0 + r == 2 * cp + 1) ? 1.f : 0.f}; SU[r][cp] = (f32x2){0.f, 0.f}; } }
    for (int g = 0; g < 8; ++g) {
        int lz = lane; asm volatile("" : "+v"(lz));
        VM_WAIT();
        f16x8 y0, y1;
        if (g > 0) { const LAS unsigned char* yb = wl + L::W + (lz >> 3) * L::TP + 16 * (lz & 7); y0 = *(const LAS f16x8*)yb; y1 = *(const LAS f16x8*)(yb + 128); LDS_WAIT(); }
        const LAS f16* raw = (const LAS f16*)(rawb + (g & 1) * 4096);
#ifdef PROBE_PREP
        const unsigned long long tq0 = __builtin_amdgcn_s_memrealtime();
#endif
        rwkv_prep8(P, h, row0 + 8 * g, raw, prm, wl, lz, lw, aa);
#ifdef PROBE_PREP
        LDS_WAIT(); F.pacc2 += __builtin_amdgcn_s_memrealtime() - tq0;
#endif
        if (g > 0) { f16* yo = ysc + (8 * (g - 1) + (lz >> 3)) * 64 + 8 * (lz & 7); *(f16x8*)yo = y0; *(f16x8*)(yo + 4096) = y1; }
        if (g < 7) scan_stage_w(P.ZR, row0 + 8 * (g + 1) - 1, h, rawb + ((g + 1) & 1) * 4096, lz);
        if (g < 7) {
            const unsigned lo = (unsigned)((8 * (g + 1) + (lz & 7)) * 64 + 8 * (lz >> 3));
            lw = *(const f16x8*)(lws + lo); aa = *(const f16x8*)(lws + 4096 + lo);
        }
        LDS_WAIT();
#ifdef PROBE_STEPS
        const unsigned long long ts0 = __builtin_amdgcn_s_memrealtime();
#endif
        for (int t = 0; t < 8; ++t) scan_step_q(SP, SU, wl, t, lz >> 2, lz & 3);
#ifdef PROBE_STEPS
        F.pacc2 += __builtin_amdgcn_s_memrealtime() - ts0;
#endif
        LDS_WAIT();
    }
    {   const LAS unsigned char* yb = wl + L::W + (lane >> 3) * L::TP + 16 * (lane & 7);
        const f16x8 y0 = *(const LAS f16x8*)yb, y1 = *(const LAS f16x8*)(yb + 128);
        f16* yo = ysc + (8 * 7 + (lane >> 3)) * 64 + 8 * (lane & 7);
        *(f16x8*)yo = y0; *(f16x8*)(yo + 4096) = y1; }
    float* pu = F.out + ((size_t)unit * 8 + h) * 8192;
    {
        const int Q = lane >> 2, sub = lane & 3;
        f16* pfh = (f16*)pu + (sub * 1024 + (Q >> 3) * 512 + (Q & 3) * 128 + 4 * ((Q >> 2) & 1));
#pragma unroll
        for (int c = 0; c < 16; ++c) *(f16x4*)(pfh + c * 8) = cvt4((f32x4){SP[0][c >> 1][c & 1], SP[1][c >> 1][c & 1], SP[2][c >> 1][c & 1], SP[3][c >> 1][c & 1]});
        float* uu = pu + 4096 + (4 * Q) * 64 + 16 * sub;
#pragma unroll
        for (int r = 0; r < 4; ++r)
#pragma unroll
            for (int j = 0; j < 4; ++j) *(f32x4*)(uu + r * 64 + 4 * j) = (f32x4){SU[r][2 * j].x, SU[r][2 * j].y, SU[r][2 * j + 1].x, SU[r][2 * j + 1].y};
    }
}
__device__ __forceinline__ void scan_step_qs(f32x2 (&SU)[4][8], const LAS unsigned char* wl, int t, int Q, int sub, f32x4& yq) {
    typedef RL<4> L;
    const LAS unsigned char* pa = wl + L::AL + t * 256 + 64 * sub; const LAS unsigned char* pw = wl + L::W + t * 256 + 64 * sub; const LAS unsigned char* pb = wl + L::BE + t * 256 + 64 * sub;
    const LAS unsigned char* pk = wl + L::RK + t * 256 + 64 * sub;
    f32x4 A[4], W[2], B[2]; f16x8 RK[2];
#pragma unroll
    for (int i = 0; i < 4; ++i) A[i] = *(const LAS f32x4*)(pa + 16 * i);
    const f16x4 v4 = *(const LAS f16x4*)(wl + L::V + (t * 64 + 4 * Q) * 2);
    f32x2 dU[4];
#pragma unroll
    for (int r = 0; r < 4; ++r) dU[r] = (f32x2){0.f, 0.f};
#pragma unroll
    for (int g = 0; g < 4; ++g) {
        const f32x2 alo = A[g].xy, ahi = A[g].zw;
#pragma unroll
        for (int r = 0; r < 4; ++r) { dU[r] = fma2(SU[r][2 * g], alo, dU[r]); dU[r] = fma2(SU[r][2 * g + 1], ahi, dU[r]); }
        if (g == 1) {
#pragma unroll
            for (int i = 0; i < 2; ++i) { W[i] = *(const LAS f32x4*)(pw + 16 * i); B[i] = *(const LAS f32x4*)(pb + 16 * i); RK[i] = *(const LAS f16x8*)(pk + 16 * i); }
        }
        CFENCE();
    }
    float saU[4], vv[4];
#pragma unroll
    for (int r = 0; r < 4; ++r) { saU[r] = quad_sum(dU[r].x + dU[r].y); vv[r] = (float)v4[r]; }
    f32x2 yU[4];
#pragma unroll
    for (int r = 0; r < 4; ++r) yU[r] = (f32x2){0.f, 0.f};
#pragma unroll
    for (int g = 0; g < 4; ++g) {
        const f32x4 w = W[g & 1], be = B[g & 1]; const f16x8 rk = RK[g & 1];
        if (g + 2 < 4) { W[g & 1] = *(const LAS f32x4*)(pw + 16 * (g + 2)); B[g & 1] = *(const LAS f32x4*)(pb + 16 * (g + 2)); RK[g & 1] = *(const LAS f16x8*)(pk + 16 * (g + 2)); }
#pragma unroll
        for (int hf = 0; hf < 2; ++hf) {
            const f32x2 wh = hf ? w.zw : w.xy, bh = hf ? be.zw : be.xy;
            const f32x2 rh = (f32x2){(float)rk[2 * hf], (float)rk[2 * hf + 1]}, kh = (f32x2){(float)rk[4 + 2 * hf], (float)rk[5 + 2 * hf]};
            const int cp = 2 * g + hf;
#pragma unroll
            for (int r = 0; r < 4; ++r) {
                const f32x2 tu = fma2(kh, (f32x2){vv[r], vv[r]}, SU[r][cp] * wh);
                SU[r][cp] = fma2(bh, (f32x2){saU[r], saU[r]}, tu);
                yU[r] = fma2(SU[r][cp], rh, yU[r]);
            }
        }
        CFENCE();
    }
#pragma unroll
    for (int r = 0; r < 4; ++r) yq[r] = quad_sum(yU[r].x + yU[r].y);
}
__device__ __forceinline__ void scan_unit_sample(Frame& F, int l, int b) {
    typedef RL<4> L;
    int lane = F.lane; asm volatile("" : "+v"(lane));
    const int h = F.wave;
    const RwkvP P = rwkv_params(F, l);
    LAS unsigned char* wl = F.lds + h * L::SIZE;
    LAS f16* sh = (LAS f16*)(F.lds + SHS_OFF);
    const int row0 = MP + 4 * b;
    __syncthreads();
    f32x4 Lr[16];
    const float* s0 = F.in[2] + (((size_t)l * DECB + b) * 8 + h) * 4096 + lane * 4;
#pragma unroll
    for (int k = 0; k < 16; ++k) Lr[k] = *(const f32x4*)(s0 + 256 * k);
    const float lg = F.in[16][l * RW + h * 64 + lane], lb = F.in[17][l * RW + h * 64 + lane];
    f16x8 wd[4][2], wg[4][4], wi[4][2];
    {   const int q = lane >> 4; const f16* DU = P.lora + (size_t)(h * 64 + (lane & 15)) * 64 + 8 * q; const f16* IU = DU + 512 * 64; const f16* GU = P.lora + 2 * 512 * 64 + (size_t)(h * 64 + (lane & 15)) * 128 + 8 * q;
#pragma unroll
        for (int nt = 0; nt < 4; ++nt) {
#pragma unroll
            for (int kk = 0; kk < 2; ++kk) { wd[nt][kk] = *(const f16x8*)(DU + nt * 16 * 64 + 32 * kk); wi[nt][kk] = *(const f16x8*)(IU + nt * 16 * 64 + 32 * kk); }
#pragma unroll
            for (int kk = 0; kk < 4; ++kk) wg[nt][kk] = *(const f16x8*)(GU + nt * 16 * 128 + 32 * kk);
        } }
    LAS unsigned char* prm = F.lds + PRMS_OFF; LAS f16* raw = (LAS f16*)(F.lds + RAWS_OFF);
    {
        const int tid = h * 64 + lane, t4 = 4 * tid;
        if (t4 < RW) { *(LAS f32x4*)(prm + PR_DB + 4 * t4) = *(const f32x4*)(P.dbase + t4); *(LAS f16x4*)(prm + PR_IB + 2 * t4) = cvt4(*(const f32x4*)(P.ibase + t4)); *(LAS f16x4*)(prm + PR_KK + 2 * t4) = cvt4(*(const f32x4*)(P.kk_ + t4));
                       *(LAS f16x4*)(prm + PR_KA + 2 * t4) = cvt4(*(const f32x4*)(P.ka_ + t4)); *(LAS f16x4*)(prm + PR_RK + 2 * t4) = cvt4(*(const f32x4*)(P.rk_ + t4)); }
        if (t4 < SHW) *(LAS f16x4*)(prm + PR_MU + 2 * t4) = cvt4(*(const f32x4*)(P.mu + t4));
        for (int i = tid; i < 5 * (SHW / 8); i += NTHR) {
            const int r = i / (SHW / 8), c8 = 8 * (i % (SHW / 8));
            f16x8 v;
            if (r == 0) { const float* sp = P.sshift + (size_t)b * SHW + c8; v = cvt8(*(const f32x4*)sp, *(const f32x4*)(sp + 4)); }
            else v = *(const f16x8*)(P.ZR + (size_t)(row0 + r - 1) * SHW + c8);
            *(LAS f16x8*)(raw + r * SHW + c8) = v;
        }
    }
    LDS_WAIT(); __syncthreads();
    rwkv_prepA<true>(P, h, row0, raw, prm, sh, lane);
    LDS_WAIT(); __syncthreads();
    rwkv_prepB<true, 4>(P, h, row0, raw, prm, sh, wl, lane, wd, wg, wi);
    asm volatile("" : "+v"(lane));
    LDS_WAIT(); VM_WAIT();
    const int Q = lane >> 2, sub = lane & 3;
    f32x2 SU[4][8];
    {
        LAS float* xt = (LAS float*)(F.lds + SXT_OFF + h * 4352);
#pragma unroll
        for (int c = 0; c < 4; ++c) {
#pragma unroll
            for (int i = 0; i < 4; ++i) *(LAS f32x4*)(xt + (4 * i + (lane >> 4)) * 68 + 4 * (lane & 15)) = Lr[4 * c + i];
            LDS_WAIT();
            if ((lane >> 4) == c) {
#pragma unroll
                for (int r = 0; r < 4; ++r)
#pragma unroll
                    for (int j = 0; j < 4; ++j) { const f32x4 t4 = *(const LAS f32x4*)(xt + (4 * (Q & 3) + r) * 68 + 16 * sub + 4 * j); SU[r][2 * j] = (f32x2){t4.x, t4.y}; SU[r][2 * j + 1] = (f32x2){t4.z, t4.w}; }
            }
            LDS_WAIT();
        }
    }
    f16* yp = P.YRA + (size_t)row0 * D + h * 64 + lane;
#pragma unroll 1
    for (int t = 0; t < 4; ++t) {
        const float bvt = (float)*(const LAS f16*)(wl + L::V + (t * 64 + lane) * 2) * *(const LAS float*)(wl + SGS_OFF + 4 * 128 + 4 * t), ggt = (float)*(const LAS f16*)(wl + SGS_OFF + (t * 64 + lane) * 2);
        f32x4 yq; scan_step_qs(SU, wl, t, Q, sub, yq);
        const float y = sub == 0 ? yq.x : sub == 1 ? yq.y : sub == 2 ? yq.z : yq.w;
        const float mu = wave_sum(y) * (1.f / 64.f), dv = y - mu, var = wave_sum(dv * dv) * (1.f / 64.f);
        yp[(size_t)t * D] = (f16)((dv * rsqf_(var + GN_EPS) * lg + lb + bvt) * ggt);
    }
    float* so = F.out + O_SWKV + (((size_t)l * DECB + b) * 8 + h) * 4096 + (4 * Q) * 64 + 16 * sub;
#pragma unroll
    for (int r = 0; r < 4; ++r)
#pragma unroll
        for (int j = 0; j < 4; ++j) *(f32x4*)(so + r * 64 + 4 * j) = (f32x4){SU[r][2 * j].x, SU[r][2 * j].y, SU[r][2 * j + 1].x, SU[r][2 * j + 1].y};
    LDS_WAIT();
}
struct SpStage { f16x8 a[8]; f32x4 u[4]; };
__device__ __forceinline__ void sp_load(SpStage& st, const float* pu, int lane, int uoff) {
    const f16* pf = (const f16*)pu + lane * 8;
#pragma unroll
    for (int f = 0; f < 8; ++f) st.a[f] = *(const f16x8*)(pf + f * 512);
#pragma unroll
    for (int I = 0; I < 4; ++I) st.u[I] = *(const f32x4*)(pu + uoff + 16 * I);
}
__device__ __forceinline__ void sp_step(const SpStage& st, f32x4 (&X)[4], float* pu, int uoff) {
    f16x8 xh[2];
#pragma unroll
    for (int s = 0; s < 2; ++s)
#pragma unroll
        for (int j = 0; j < 8; ++j) xh[s][j] = (f16)X[2 * s + (j >> 2)][j & 3];
#pragma unroll
    for (int I = 0; I < 4; ++I) {
        f32x4 a = st.u[I];
#pragma unroll
        for (int s = 0; s < 2; ++s) a = __builtin_amdgcn_mfma_f32_16x16x32_f16(st.a[I * 2 + s], xh[s], a, 0, 0, 0);
        X[I] = a; { const int q_ = (uoff >> 2) & 3; *(f16x4*)((f16*)(pu + 4096) + 2 * (uoff - 4096 - 4 * q_) + 16 * I + 4 * q_) = cvt4(a); }
    }
}
__device__ __forceinline__ void spass_task(Frame& F, int l, int task) {
    const int w = task & 3, h = (task >> 2) & 7, b = task >> 5, lane = F.lane, m = lane & 15, q = lane >> 4;
    const int uoff = 4096 + (16 * w + m) * 64 + 4 * q;
    f32x4 X[4];
#pragma unroll
    for (int J = 0; J < 4; ++J) X[J] = (f32x4){0.f, 0.f, 0.f, 0.f};
    float* pu0 = F.out + ((size_t)(b * NCH) * 8 + h) * 8192;
    constexpr size_t CS = 8 * 8192;
    SpStage s0, s1, s2, s3;
    sp_load(s0, pu0, lane, uoff); sp_load(s1, pu0 + CS, lane, uoff); sp_load(s2, pu0 + 2 * CS, lane, uoff); sp_load(s3, pu0 + 3 * CS, lane, uoff);
    for (int c = 0; c < NCH; c += 4) {
        float* pu = pu0 + (size_t)c * CS;
        sp_step(s0, X, pu, uoff);          if (c + 4 < NCH) sp_load(s0, pu + 4 * CS, lane, uoff);
        sp_step(s1, X, pu + CS, uoff);     if (c + 5 < NCH) sp_load(s1, pu + 5 * CS, lane, uoff);
        sp_step(s2, X, pu + 2 * CS, uoff); if (c + 6 < NCH) sp_load(s2, pu + 6 * CS, lane, uoff);
        sp_step(s3, X, pu + 3 * CS, uoff); if (c + 7 < NCH) sp_load(s3, pu + 7 * CS, lane, uoff);
    }
    float* so = F.out + O_PWKV + (((size_t)l * NB + b) * 8 + h) * 4096 + (16 * w + m) * 64 + 4 * q;
#pragma unroll
    for (int I = 0; I < 4; ++I) *(f32x4*)(so + 16 * I) = X[I];
}
constexpr int SPR = 12, SP_SLOT = 12288, SP_FLAG = SPR * SP_SLOT;
static_assert(SP_FLAG + 128 <= MISC_OFF, "state-pass ring");
__device__ __forceinline__ void spass_ring(Frame& F, int l, int task) {
    const int w = task & 3, h = (task >> 2) & 7, b = task >> 5;
    int lane = F.lane; asm volatile("" : "+v"(lane));
    const int m = lane & 15, q = lane >> 4;
    const int uoff = 4096 + (16 * w + m) * 64 + 4 * q;
    float* pu0 = F.out + ((size_t)(b * NCH) * 8 + h) * 8192;
    constexpr size_t CS = 8 * 8192;
    volatile LAS unsigned* ready = (volatile LAS unsigned*)(F.lds + SP_FLAG);
    volatile LAS unsigned* consumed = ready + 16;
    __syncthreads();
    if (F.tid < 32) ready[F.tid] = 0u;
    LDS_WAIT(); __syncthreads();
    if (F.wave == 0) {
        f32x4 X[4];
#pragma unroll
        for (int J = 0; J < 4; ++J) X[J] = (f32x4){0.f, 0.f, 0.f, 0.f};
        auto rdops = [&](SpStage& st, int c) {
            const LAS unsigned char* slot = F.lds + (c % SPR) * SP_SLOT + lane * 16;
#pragma unroll
            for (int f = 0; f < 8; ++f) st.a[f] = *(const LAS f16x8*)(slot + f * 1024);
#pragma unroll
            for (int I = 0; I < 4; ++I) st.u[I] = *(const LAS f32x4*)(slot + 8192 + I * 1024);
        };
        auto waitrdy = [&](unsigned fv, int c) {
#ifdef PROBE_SPW
            const unsigned long long tw0 = __builtin_amdgcn_s_memrealtime();
#endif
            for (int spin = 0; fv != (unsigned)(c + 1) && spin < (1 << 21); ++spin) { __builtin_amdgcn_s_sleep(1); fv = ready[c % SPR]; }
#ifdef PROBE_SPW
            F.pacc2 += __builtin_amdgcn_s_memrealtime() - tw0;
#endif
            asm volatile("" ::: "memory");
        };
        unsigned fv = ready[0];
        auto step = [&](const SpStage& st, SpStage& nx, int c) {
            unsigned fn = 0u;
            if (c + 1 < NCH) { waitrdy(fv, c + 1); rdops(nx, c + 1); if (c + 2 < NCH) fn = ready[(c + 2) % SPR]; }
            f16x8 xh[2];
#pragma unroll
            for (int s = 0; s < 2; ++s)
#pragma unroll
                for (int j = 0; j < 8; ++j) xh[s][j] = (f16)X[2 * s + (j >> 2)][j & 3];
            f32x4 a[4];
#pragma unroll
            for (int I = 0; I < 4; ++I) a[I] = __builtin_amdgcn_mfma_f32_16x16x32_f16(st.a[I * 2], xh[0], st.u[I], 0, 0, 0);
#pragma unroll
            for (int I = 0; I < 4; ++I) a[I] = __builtin_amdgcn_mfma_f32_16x16x32_f16(st.a[I * 2 + 1], xh[1], a[I], 0, 0, 0);
            float* pu = pu0 + (size_t)c * CS;
#pragma unroll
            for (int I = 0; I < 4; ++I) { X[I] = a[I]; *(f16x4*)((f16*)(pu + 4096) + 2 * (uoff - 4096 - 4 * q) + 16 * I + 4 * q) = cvt4(a[I]); }
            LDS_WAIT();
            if (lane == 0 && c + 1 < NCH) *consumed = (unsigned)(c + 2);
            fv = fn;
        };
        SpStage s0, s1;
        waitrdy(fv, 0); rdops(s0, 0); fv = ready[1 % SPR]; LDS_WAIT(); if (lane == 0) *consumed = 1u;
#pragma unroll 1
        for (int c = 0; c < NCH; c += 2) { step(s0, s1, c); step(s1, s0, c + 1); }
        float* so = F.out + O_PWKV + (((size_t)l * NB + b) * 8 + h) * 4096 + (16 * w + m) * 64 + 4 * q;
#pragma unroll
        for (int I = 0; I < 4; ++I) *(f32x4*)(so + 16 * I) = X[I];
    } else {
        const int lw = F.wave - 1;
        auto issue = [&](int c) {
            const float* pu = pu0 + (size_t)c * CS; const f16* pf = (const f16*)pu + lane * 8;
            LAS unsigned char* slot = F.lds + (c % SPR) * SP_SLOT;
#pragma unroll
            for (int f = 0; f < 8; ++f) __builtin_amdgcn_global_load_lds((const unsigned*)(pf + f * 512), (LAS unsigned*)(slot + f * 1024), 16, 0, 0);
#pragma unroll
            for (int I = 0; I < 4; ++I) __builtin_amdgcn_global_load_lds((const unsigned*)(pu + uoff + 16 * I), (LAS unsigned*)(slot + 8192 + I * 1024), 16, 0, 0);
        };
        issue(lw);
#pragma unroll 1
        for (int c = lw; c < NCH; c += 7) {
            const int cn = c + 7;
            if (cn < NCH) {
                if (cn >= SPR) for (int spin = 0; (int)*consumed < cn - SPR + 1 && spin < (1 << 21); ++spin) __builtin_amdgcn_s_sleep(1);
                issue(cn);
                asm volatile("s_waitcnt vmcnt(12)" ::: "memory");
            } else VM_WAIT();
            if (lane == 0) ready[c % SPR] = (unsigned)(c + 1);
            LDS_WAIT();
        }
    }
}
constexpr int SG_P = 136;
__device__ __forceinline__ void combine_unit(Frame& F, int l, int unit) {
    const int h = F.wave, c = unit & 127, b = unit >> 7, lane = F.lane, ql = lane & 31, hf = lane >> 5;
    const int row0 = b * SEQ + c * CH;
    const f16* ZR = WSP(f16, WS_ZR);
    LAS f16* SG = (LAS f16*)F.lds;
    const f16* ysc = (const f16*)(F.ws + WS_YSC) + ((size_t)unit * 8 + h) * 8192;
    f16* YRA = WSP(f16, WS_YRA);
    __syncthreads();
    f16x8 gu[2][8], sf[4][2], yf[4][2];
    {   const f16* GU = (const f16*)(F.ws + WS_LORA + (size_t)l * LORA_STRIDE) + 2 * 512 * 64 + (size_t)(h * 64 + ql) * 128 + 8 * hf;
#pragma unroll
        for (int kk = 0; kk < 8; ++kk) gu[0][kk] = *(const f16x8*)(GU + 16 * kk);
        const f16* Sc = (const f16*)(F.out + ((size_t)(unit > 0 ? unit - 1 : 0) * 8 + h) * 8192 + 4096);
#pragma unroll
        for (int kk = 0; kk < 4; ++kk) {
#pragma unroll
            for (int vt = 0; vt < 2; ++vt) sf[kk][vt] = *(const f16x8*)(Sc + (32 * vt + ql) * 128 + 16 * kk + 8 * hf);
#pragma unroll
            for (int tt = 0; tt < 2; ++tt) yf[kk][tt] = *(const f16x8*)(ysc + (32 * tt + ql) * 64 + 16 * kk + 8 * hf);
        }
    }
    {
        const int tk = F.tid >> 3, cb = 3 * RW + 128, row = row0 + tk;
        const float* mu = F.in[7] + (size_t)l * SHW + cb;
#pragma unroll
        for (int hh = 0; hh < 2; ++hh) {
            const int c8 = 8 * (F.tid & 7) + 64 * hh;
            const f16x8 z = *(const f16x8*)(ZR + (size_t)row * SHW + cb + c8);
            f16x8 pv; if ((row & (SEQ - 1)) == 0) { for (int e = 0; e < 8; ++e) pv[e] = (f16)0.f; } else pv = *(const f16x8*)(ZR + (size_t)(row - 1) * SHW + cb + c8);
            const f32x4 m0 = *(const f32x4*)(mu + c8), m1 = *(const f32x4*)(mu + c8 + 4);
            f16x8 o;
#pragma unroll
            for (int e = 0; e < 8; ++e) { const float zz = (float)z[e], pp = (float)pv[e], mm = e < 4 ? m0[e & 3] : m1[e & 3]; o[e] = (f16)sigmoidf_(zz + (pp - zz) * mm); }
            *(LAS f16x8*)(SG + tk * SG_P + c8) = o;
        }
    }
    {   const f16* GU1 = (const f16*)(F.ws + WS_LORA + (size_t)l * LORA_STRIDE) + 2 * 512 * 64 + (size_t)(h * 64 + 32 + ql) * 128 + 8 * hf;
        asm volatile("" : "+v"(GU1));
#pragma unroll
        for (int kk = 0; kk < 8; ++kk) gu[1][kk] = *(const f16x8*)(GU1 + 16 * kk); }
    LDS_WAIT(); __syncthreads();
    f32x16 acc[2][2];
#pragma unroll
    for (int vt = 0; vt < 2; ++vt)
#pragma unroll
        for (int tt = 0; tt < 2; ++tt)
#pragma unroll
            for (int i = 0; i < 16; ++i) acc[vt][tt][i] = 0.f;
    if (c > 0) {
#pragma unroll
        for (int kk = 0; kk < 4; ++kk)
#pragma unroll
            for (int vt = 0; vt < 2; ++vt)
#pragma unroll
                for (int tt = 0; tt < 2; ++tt) acc[vt][tt] = __builtin_amdgcn_mfma_f32_32x32x16_f16(sf[kk][vt], yf[kk][tt], acc[vt][tt], 0, 0, 0);
    }
    const float* lg = F.in[16] + l * RW + h * 64; const float* lb = F.in[17] + l * RW + h * 64;
#pragma unroll
    for (int tt = 0; tt < 2; ++tt) {
        const int t = 32 * tt + ql, row = row0 + t;
        f16x4 yu[8], bvv[8];
#pragma unroll
        for (int vt = 0; vt < 2; ++vt)
#pragma unroll
            for (int g4 = 0; g4 < 4; ++g4) { yu[vt * 4 + g4] = *(const f16x4*)(ysc + 4096 + t * 64 + 32 * vt + 8 * g4 + 4 * hf); bvv[vt * 4 + g4] = *(const f16x4*)(YRA + (size_t)row * D + h * 64 + 32 * vt + 8 * g4 + 4 * hf); }
        f32x16 gac[2];
#pragma unroll
        for (int vt = 0; vt < 2; ++vt)
#pragma unroll
            for (int i = 0; i < 16; ++i) gac[vt][i] = 0.f;
#pragma unroll
        for (int kk = 0; kk < 8; ++kk) {
            const f16x8 gf = *(const LAS f16x8*)(SG + t * SG_P + 16 * kk + 8 * hf);
#pragma unroll
            for (int vt = 0; vt < 2; ++vt) gac[vt] = __builtin_amdgcn_mfma_f32_32x32x16_f16(gu[vt][kk], gf, gac[vt], 0, 0, 0);
        }
        float s = 0.f;
#pragma unroll
        for (int vt = 0; vt < 2; ++vt)
#pragma unroll
            for (int g4 = 0; g4 < 4; ++g4) { const f32x4 y4 = up4(yu[vt * 4 + g4]);
                acc[vt][tt][4 * g4] += y4.x; acc[vt][tt][4 * g4 + 1] += y4.y; acc[vt][tt][4 * g4 + 2] += y4.z; acc[vt][tt][4 * g4 + 3] += y4.w;
                s += (acc[vt][tt][4 * g4] + acc[vt][tt][4 * g4 + 1]) + (acc[vt][tt][4 * g4 + 2] + acc[vt][tt][4 * g4 + 3]); }
        s += shfl_xor_l(s, 32, lane);
        const float mu = s * (1.f / 64.f); float qv = 0.f;
#pragma unroll
        for (int vt = 0; vt < 2; ++vt)
#pragma unroll
            for (int i = 0; i < 16; ++i) { const float d = acc[vt][tt][i] - mu; qv += d * d; }
        qv += shfl_xor_l(qv, 32, lane);
        const float rstd = rsqf_(qv * (1.f / 64.f) + GN_EPS);
#pragma unroll
        for (int vt = 0; vt < 2; ++vt)
#pragma unroll
            for (int g4 = 0; g4 < 4; ++g4) {
                const int v = 32 * vt + 8 * g4 + 4 * hf;
                const f32x4 y = (f32x4){acc[vt][tt][4 * g4], acc[vt][tt][4 * g4 + 1], acc[vt][tt][4 * g4 + 2], acc[vt][tt][4 * g4 + 3]};
                const f32x4 gg = (f32x4){gac[vt][4 * g4], gac[vt][4 * g4 + 1], gac[vt][4 * g4 + 2], gac[vt][4 * g4 + 3]};
                f16* yp = YRA + (size_t)row * D + h * 64 + v;
                const f32x4 bv = up4(bvv[vt * 4 + g4]);
                *(f16x4*)yp = cvt4(((y - mu) * rstd * *(const f32x4*)(lg + v) + *(const f32x4*)(lb + v) + bv) * gg);
            }
    }
}

__device__ __forceinline__ void sample_cache_copy(Frame& F, int l, int idx, int n) {
    const size_t gt = (size_t)idx * NTHR + F.tid, NT = (size_t)n * NTHR; constexpr int PER = (WBUF - DECT) * 128 / 4;
    for (size_t i = gt; i < (size_t)2 * DECB * PER; i += NT) {
        const int kv = (int)(i / ((size_t)DECB * PER)), r = (int)(i % ((size_t)DECB * PER)), b = r / PER, e = (r % PER) * 4;
        const float* src = F.in[4 + kv] + ((size_t)l * DECB + b) * WBUF * 128 + DECT * 128 + e;
        float* dst = F.out + (kv ? O_SV : O_SK) + ((size_t)l * DECB + b) * WBUF * 128 + e;
        *(f32x4*)dst = *(const f32x4*)src;
    }
}
#ifndef MK_PER_PHASE
#define MK_PER_PHASE 0
#endif
constexpr int NPHASE = 1 + DEPTH * 10;
struct KArgs { Args a; double invf[32]; };
__global__ void __launch_bounds__(NTHR, 2) mk_fwd(KArgs ka) {
    extern __shared__ __attribute__((aligned(16))) unsigned char lds_raw[];
    Frame F;
    F.lds = (LAS unsigned char*)lds_raw;
    F.tid = threadIdx.x; F.lane = F.tid & 63; F.wave = __builtin_amdgcn_readfirstlane(F.tid >> 6);
    F.G = gridDim.x; F.bid = blockIdx.x; F.gw = F.bid * NWAVES + F.wave; F.NGW = F.G * NWAVES;
    F.in = ka.a.in; F.out = ka.a.out; F.ws = ka.a.ws; F.pacc2 = 0;
    volatile LAS unsigned* MISC = (volatile LAS unsigned*)(F.lds + MISC_OFF);
    if (F.tid < 64) MISC[F.tid] = 0u;
    __syncthreads();
    XcdBarrier bar = xcd_barrier_post((unsigned*)(F.ws + WS_CTL) + CW_BAR, MISC + 8);
    const int lo = ka.a.ph_lo, hi = ka.a.ph_hi;
    int ph = 0;
#ifndef PROBE_SEL
#define PROBE_SEL 0
#endif
    unsigned long long pacc = 0, pt0 = 0;
#define TICK(mask) do { if (PROBE_SEL & (mask)) pt0 = __builtin_amdgcn_s_memrealtime(); } while (0)
#define TOCK(mask) do { if (PROBE_SEL & (mask)) pacc += __builtin_amdgcn_s_memrealtime() - pt0; } while (0)
#define PHASE_BEGIN fresh_tid(F); if (lo <= ph && ph < hi) { { \
        size_t _z = 0; int _b = blockIdx.x; asm volatile("" : "+s"(_z), "+s"(_b)); F.out = ka.a.out + _z; F.ws = ka.a.ws + _z; F.bid = _b; F.gw = _b * NWAVES + F.wave; }
#define PHASE_END   if (ph + 1 < hi) xcd_barrier(bar, F.wave == 0 && fresh_lane() == 0); } ++ph;

    TICK(1); PHASE_BEGIN prologue(F, ka.invf); PHASE_END TOCK(1);

    for (int l = 0; l < DEPTH; ++l) {
        f16* XH = WSP(f16, WS_XH); f16* YRA = WSP(f16, WS_YRA); f16* MIX = WSP(f16, WS_MIX); f16* HB = WSP(f16, WS_H);
        const f16* WIN = WSP(f16, WS_WIN); const f16* WBR = WSP(f16, WS_WBR); const f16* WOUT = WSP(f16, WS_WOUT); const f16* WUP = WSP(f16, WS_WUP); const f16* WDN = WSP(f16, WS_WDN);
        TICK(2); PHASE_BEGIN {
            const EpiG1 e{WSP(f16, WS_ZR), YRA, WSP(f16, WS_KB), WSP(f16, WS_VB), WSP(f32x2, WS_ROPE), F.out, l, WSP(f16, WS_GRS), WSP(f16, WS_GAS)};
            const SchedG1Z SZ{XH, WIN, F.G, F.bid};
            pg8::gemm_phase(F.lds, D, D, SZ, EpiBig16<EpiG1>{e}, F.tid);
            const SchedG1R SR{XH, WIN, F.G, (F.bid + 34) % F.G};
            pg8::gemm_phase(F.lds, D, D, SR, EpiBigR<EpiG1>{e}, F.tid);
            if (F.G == 256) {
                const EpiMix eg{WSP(f16, WS_GG), WSP(f16, WS_GG), WSP(f16, WS_GRS), WSP(f16, WS_GAS), WSP(f16, WS_GG)};
                const SchedGate SG{XH, WIN, F.bid >= 164 ? F.bid - 164 : -1, 0};
                pg8::gemm_phase(F.lds, D, D, SG, EpiBig16<EpiMix>{eg}, F.tid);
            }
        } PHASE_END TOCK(2);
        const bool mix_early = F.G >= 128, pre_gate = F.G == 256;
        TICK(4); PHASE_BEGIN {
            TICK(2048); for (int u = F.bid; u < NB * NCH; u += F.G) scan_unit_prompt(F, l, u);
            __syncthreads(); TOCK(2048); fresh_tid(F);
            TICK(4096); if (!mix_early) for (int u = F.bid; u < NB * 64 * 2; u += F.G) attn_prompt_unit(F, l, u);
            __syncthreads(); TOCK(4096); fresh_tid(F);
            TICK(8192); for (int u = (F.bid + F.G - 64) % F.G; u < DECB; u += F.G) scan_unit_sample(F, l, u);
            __syncthreads(); TOCK(8192); fresh_tid(F);
            for (int t = ((F.bid + F.G - 32) % F.G) * NWAVES + F.wave; t < DECB * 2; t += F.NGW) attn_sample_task(F, l, t);
            if (F.G == 256 && (F.bid < 32 || F.bid >= 192)) {
                const int idx = F.bid < 32 ? F.bid : F.bid - 160;
                convert_layer_weights(F, l, 1, idx * NWAVES + F.wave, 96 * NWAVES);
            }
            if (F.G != 256) sample_cache_copy(F, l, F.bid, F.G);
        } PHASE_END TOCK(4);
        TICK(8); PHASE_BEGIN {
            if (!mix_early || F.bid < 64) {
#ifdef PROBE_SP
                const unsigned long long tq0 = __builtin_amdgcn_s_memrealtime();
#endif
                if (mix_early) spass_ring(F, l, F.bid);
                else for (int t = F.bid + F.G * F.wave; t < NB * 8 * 4; t += F.G * NWAVES) spass_task(F, l, t);
#ifdef PROBE_SP
                VM_WAIT(); F.pacc2 += __builtin_amdgcn_s_memrealtime() - tq0;
#endif
            }
            else {
                const EpiMix e{MIX, WSP(f16, WS_ZR), WSP(f16, WS_GRS), WSP(f16, WS_GAS), WSP(f16, WS_GG)};
                const SchedMix S{XH, YRA, WIN, WBR, F.G - 64, F.bid - 64, 0, 1, 0};
                pg8::gemm_phase(F.lds, D, D, S, EpiBig16<EpiMix>{e}, F.tid);
                __syncthreads(); fresh_tid(F);
                if (F.bid >= 72) for (int u = F.bid - 72; u < NB * 64 * 2; u += F.G - 72) attn_prompt_unit(F, l, u);
                if (pre_gate) {
                    __syncthreads(); fresh_tid(F);
                    const SchedGate SG{XH, WIN, F.bid >= 92 ? F.bid - 92 : -1, GHP};
                    pg8::gemm_phase(F.lds, D, D, SG, EpiBig16<EpiMix>{e}, F.tid);
                }
            }
        } PHASE_END TOCK(8);
        TICK(16); PHASE_BEGIN { for (int u = F.bid; u < NB * NCH; u += F.G) combine_unit(F, l, u); } PHASE_END TOCK(16);
        TICK(32); PHASE_BEGIN {
            const EpiMix e{MIX, WSP(f16, WS_ZR), WSP(f16, WS_GRS), WSP(f16, WS_GAS), pre_gate ? WSP(f16, WS_GG) : MIX};
            const SchedMix S{XH, YRA, WIN, WBR, F.G, F.bid, -1, mix_early ? 0 : 1, pre_gate ? 1 : 0};
            pg8::gemm_phase(F.lds, D, D, S, EpiBig16<EpiMix>{e}, F.tid);
        } PHASE_END TOCK(32);
        TICK(64); PHASE_BEGIN {
            const EpiRes e{XH, WSP(float, WS_SLAB)};
            const SchedSplit S{MIX, WOUT, D, D, 4, F.G, F.bid};
            pg8::gemm_phase(F.lds, D, D, S, EpiBig16<EpiRes>{e}, F.tid);
        } PHASE_END TOCK(64);
        TICK(128); PHASE_BEGIN ln_rows(F, F.in[22] + (size_t)l * D, F.in[23] + (size_t)l * D, false, 4); PHASE_END TOCK(128);
        TICK(256); PHASE_BEGIN {
            const EpiUp e{HB};
            const SchedPlain S{XH, WUP, D, D, M / 256, 16, 16, F.G, F.bid};
            pg8::gemm_phase(F.lds, D, D, S, EpiBig16<EpiUp>{e}, F.tid);
            if (F.G == 256 && F.bid >= 32) { fresh_tid(F); sample_cache_copy(F, l, F.bid - 32, 224); }
        } PHASE_END TOCK(256);
        TICK(512); PHASE_BEGIN {
            const EpiRes e{XH, WSP(float, WS_SLAB)};
            const SchedSplit S{HB, WDN, FF, FF, 8, F.G, F.bid};
            pg8::gemm_phase(F.lds, FF, FF, S, EpiBig16<EpiRes>{e}, F.tid);
        } PHASE_END TOCK(512);
        TICK(1024); PHASE_BEGIN {
            ln_rows(F, F.in[26] + (size_t)l * D, F.in[27] + (size_t)l * D, l == DEPTH - 1, 8);
            if (l + 1 < DEPTH) { __syncthreads(); convert_layer_weights(F, l + 1, F.G == 256 ? 0 : 2, F.gw, F.NGW); }
        } PHASE_END TOCK(1024);
    }
#if defined(PROBE_PREP) || defined(PROBE_STEPS) || defined(PROBE_SP) || defined(PROBE_SPW)
    pacc = F.pacc2;
#endif
    if (PROBE_SEL && blockIdx.x == 0) { const unsigned long long te = __builtin_amdgcn_s_memrealtime(); while (__builtin_amdgcn_s_memrealtime() - te < 4ull * pacc) __builtin_amdgcn_s_sleep(32); }
}

extern "C" void kernel_launch(void* const* d_in, const int* in_sizes, int n_in, void* d_out, int out_size, void* d_ws, size_t ws_size, hipStream_t stream) {
    static int grid = 0;
    if (grid == 0) {
        if (n_in != 28 || (size_t)out_size != O_END || ws_size < WS_END) fprintf(stderr, "kernel_launch: unexpected shapes: n_in %d out %d (want %zu) ws %zu (want >= %zu)\n", n_in, out_size, (size_t)O_END, ws_size, (size_t)WS_END);
        if (n_in != 28 || ws_size < WS_END) { grid = -1; return; }
        int dev = 0, cus = 0, per_cu = 0;
        if (hipGetDevice(&dev) != hipSuccess || hipDeviceGetAttribute(&cus, hipDeviceAttributeMultiprocessorCount, dev) != hipSuccess) { grid = -1; return; }
        if (hipFuncSetAttribute((const void*)mk_fwd, hipFuncAttributeMaxDynamicSharedMemorySize, LDS_BYTES) != hipSuccess) { fprintf(stderr, "kernel_launch: hipFuncSetAttribute failed\n"); grid = -1; return; }
        if (hipOccupancyMaxActiveBlocksPerMultiprocessor(&per_cu, (const void*)mk_fwd, NTHR, LDS_BYTES) != hipSuccess || per_cu < 1) fprintf(stderr, "kernel_launch: occupancy query says %d\n", per_cu);
        (void)hipGetLastError();
        grid = cus;
    }
    if (grid < 0) return;
    if (hipMemsetAsync((char*)d_ws + WS_CTL, 0, CTL_ZERO_BYTES, stream) != hipSuccess) return;
    KArgs ka{};
    for (int i = 0; i < 28; ++i) ka.a.in[i] = (const float*)d_in[i];
    ka.a.out = (float*)d_out; ka.a.ws = (unsigned char*)d_ws;
    for (int d = 0; d < 32; ++d) ka.invf[d] = pow(10000.0, -(double)d / 32.0);
#if MK_PER_PHASE
    for (int p = 0; p < NPHASE; ++p) { ka.a.ph_lo = p; ka.a.ph_hi = p + 1; ka.a.li = 0; hipLaunchKernelGGL(mk_fwd, dim3(grid), dim3(NTHR), LDS_BYTES, stream, ka); }
#else
    ka.a.ph_lo = 0; ka.a.ph_hi = NPHASE; ka.a.li = 0;
    hipLaunchKernelGGL(mk_fwd, dim3(grid), dim3(NTHR), LDS_BYTES, stream, ka);
#endif
}
```
